# Optimizing an MI355X kernel written in HIP

```python
import math
import jax, jax.numpy as jnp
from jax import lax
import numpy as np

D_MODEL = 1024
BATCH = 8
SEQ = 4096
DEPTH = 1

N_HEADS = 8
HEAD_DIM = 64
V_DIM = 2 * HEAD_DIM
QK_WIDTH = N_HEADS * 2 * HEAD_DIM
ATTN_WIDTH = N_HEADS * V_DIM
LRU_WIDTH = D_MODEL
LRU_BLOCKS = 8
LRU_BLOCK = LRU_WIDTH // LRU_BLOCKS
CONV_WIDTH = 4
LRU_C = 8.0
D_FF = 4 * D_MODEL
N_BUCKETS = 32
MAX_DISTANCE = 128
Q_BLOCK = 128
EPS = 1e-6
IN_WIDTH = 3 * QK_WIDTH // 2 * 0 + QK_WIDTH + QK_WIDTH + ATTN_WIDTH + 2 * LRU_WIDTH + 2 * D_MODEL

kernel_name = 'hybrid_diffattn_rglru_gated_block'


def rmsnorm(x, g):
    x32 = x.astype(jnp.float32)
    y = x32 * lax.rsqrt(jnp.mean(jnp.square(x32), axis=-1, keepdims=True) + EPS)
    return (y * g.astype(jnp.float32)).astype(x.dtype)


def rel_bucket(n):
    max_exact = N_BUCKETS // 2
    n = jnp.maximum(n, 0)
    nf = jnp.maximum(n, 1).astype(jnp.float32)
    large = max_exact + (jnp.log(nf / max_exact) / math.log(MAX_DISTANCE / max_exact)
                         * (N_BUCKETS - max_exact)).astype(jnp.int32)
    large = jnp.minimum(large, N_BUCKETS - 1)
    return jnp.where(n < max_exact, n, large)


def diff_attention(q, k, v, q_g, k_g, rel_bias, lam, subln_g, lambda_init):
    B, S = q.shape[0], q.shape[1]
    q = rmsnorm(q, q_g)
    k = rmsnorm(k, k_g)
    nb = S // Q_BLOCK
    qb = jnp.transpose(q.reshape(B, nb, Q_BLOCK, N_HEADS, 2, HEAD_DIM), (1, 0, 2, 3, 4, 5))
    k_pos = jnp.arange(S, dtype=jnp.int32)
    scale = HEAD_DIM ** -0.5
    bias_tab = rel_bias.astype(jnp.float32)

    def one_block(args):
        q_blk, blk = args
        q_pos = blk * Q_BLOCK + jnp.arange(Q_BLOCK, dtype=jnp.int32)
        rel = q_pos[:, None] - k_pos[None, :]
        bias = jnp.transpose(bias_tab[rel_bucket(rel)], (2, 0, 1))
        logits = jnp.einsum('bqhcd,bkhcd->bhcqk', q_blk, k).astype(jnp.float32) * scale
        logits = logits + bias[None, :, None]
        logits = jnp.where(rel >= 0, logits, -jnp.inf)
        p = jax.nn.softmax(logits, axis=-1)
        attn = p[:, :, 0] - lam * p[:, :, 1]
        return jnp.einsum('bhqk,bkhe->bqhe', attn.astype(v.dtype), v)

    out = lax.map(one_block, (qb, jnp.arange(nb, dtype=jnp.int32)))
    out = jnp.transpose(out, (1, 0, 2, 3, 4)).reshape(B, S, N_HEADS, V_DIM)
    out = rmsnorm(out, subln_g) * (1.0 - lambda_init)
    return out.reshape(B, S, ATTN_WIDTH)


def rg_lru_branch(xr, gr, conv_w, conv_b, w_a, b_a, w_x, b_x, lru_lambda):
    B, S, W = xr.shape
    gate = jax.nn.gelu(gr)
    xpad = jnp.pad(xr, ((0, 0), (CONV_WIDTH - 1, 0), (0, 0)))
    xc = conv_b
    for tap in range(CONV_WIDTH):
        xc = xc + xpad[:, tap:tap + S] * conv_w[tap]
    xblk = xc.reshape(B, S, LRU_BLOCKS, LRU_BLOCK)
    r = jax.nn.sigmoid(jnp.einsum('bsne,nef->bsnf', xblk, w_a) + b_a).reshape(B, S, W)
    i = jax.nn.sigmoid(jnp.einsum('bsne,nef->bsnf', xblk, w_x) + b_x).reshape(B, S, W)
    log_a = -LRU_C * r.astype(jnp.float32) * jax.nn.softplus(-lru_lambda.astype(jnp.float32))
    a = jnp.exp(log_a)
    mult = jnp.sqrt(-jnp.expm1(2.0 * log_a))
    b = mult * (i * xc).astype(jnp.float32)

    def combine(c1, c2):
        a1, b1 = c1
        a2, b2 = c2
        return a1 * a2, a2 * b1 + b2

    _, h = lax.associative_scan(combine, (a, b), axis=1)
    return (h.astype(xr.dtype)) * gate


def setup_inputs(seed: int = 0) -> dict:
    key = jax.random.key(seed)
    ks = jax.random.split(key, 24)
    f32 = jnp.float32
    nrm = lambda k, shape, scale: jax.random.normal(k, shape, f32) * scale
    gain = lambda k, shape: 1.0 + 0.05 * jax.random.normal(k, shape, f32)
    x = jax.random.normal(ks[0], (BATCH, SEQ, D_MODEL), f32)
    u = jax.random.uniform(ks[15], (DEPTH, LRU_WIDTH), f32, minval=0.9, maxval=0.999)
    a0 = u ** (1.0 / LRU_C)
    lru_lambda = jnp.log(a0) - jnp.log1p(-a0)
    return {
        'x': x,
        'norm_mix_g': gain(ks[1], (DEPTH, D_MODEL)),
        'w_in': nrm(ks[2], (DEPTH, D_MODEL, IN_WIDTH), D_MODEL ** -0.5),
        'q_norm_g': gain(ks[3], (DEPTH, HEAD_DIM)),
        'k_norm_g': gain(ks[4], (DEPTH, HEAD_DIM)),
        'lambda_q1': nrm(ks[5], (DEPTH, HEAD_DIM), 0.1),
        'lambda_k1': nrm(ks[6], (DEPTH, HEAD_DIM), 0.1),
        'lambda_q2': nrm(ks[7], (DEPTH, HEAD_DIM), 0.1),
        'lambda_k2': nrm(ks[8], (DEPTH, HEAD_DIM), 0.1),
        'subln_g': gain(ks[9], (DEPTH, V_DIM)),
        'conv_w': nrm(ks[10], (DEPTH, CONV_WIDTH, LRU_WIDTH), CONV_WIDTH ** -0.5),
        'conv_b': nrm(ks[11], (DEPTH, LRU_WIDTH), 0.02),
        'w_rg_a': nrm(ks[12], (DEPTH, LRU_BLOCKS, LRU_BLOCK, LRU_BLOCK), LRU_BLOCK ** -0.5),
        'b_rg_a': nrm(ks[13], (DEPTH, LRU_BLOCKS, LRU_BLOCK), 0.02),
        'w_rg_x': nrm(ks[14], (DEPTH, LRU_BLOCKS, LRU_BLOCK, LRU_BLOCK), LRU_BLOCK ** -0.5),
        'b_rg_x': nrm(ks[16], (DEPTH, LRU_BLOCKS, LRU_BLOCK), 0.02),
        'lru_lambda': lru_lambda,
        'w_proj_attn': nrm(ks[17], (DEPTH, ATTN_WIDTH, D_MODEL), ATTN_WIDTH ** -0.5),
        'w_proj_rnn': nrm(ks[18], (DEPTH, LRU_WIDTH, D_MODEL), LRU_WIDTH ** -0.5),
        'w_out': nrm(ks[19], (DEPTH, D_MODEL, D_MODEL), D_MODEL ** -0.5),
        'norm_mlp_g': gain(ks[20], (DEPTH, D_MODEL)),
        'w_up': nrm(ks[21], (DEPTH, D_MODEL, D_FF), D_MODEL ** -0.5),
        'w_down': nrm(ks[22], (DEPTH, D_FF, D_MODEL), D_FF ** -0.5),
        'rel_bias': nrm(ks[23], (N_BUCKETS, N_HEADS), 0.5),
    }


def reference(x, norm_mix_g, w_in, q_norm_g, k_norm_g, lambda_q1, lambda_k1, lambda_q2, lambda_k2,
              subln_g, conv_w, conv_b, w_rg_a, b_rg_a, w_rg_x, b_rg_x, lru_lambda,
              w_proj_attn, w_proj_rnn, w_out, norm_mlp_g, w_up, w_down, rel_bias):
    B, S, _ = x.shape
    offs = np.cumsum([QK_WIDTH, QK_WIDTH, ATTN_WIDTH, LRU_WIDTH, LRU_WIDTH, D_MODEL]).tolist()
    for l in range(DEPTH):
        lambda_init = 0.8 - 0.6 * math.exp(-0.3 * l)
        h = rmsnorm(x, norm_mix_g[l])
        proj = jnp.einsum('bsd,de->bse', h, w_in[l])
        q, k, v, xr, gr, g_attn, g_rnn = jnp.split(proj, offs, axis=-1)
        q = q.reshape(B, S, N_HEADS, 2, HEAD_DIM)
        k = k.reshape(B, S, N_HEADS, 2, HEAD_DIM)
        v = v.reshape(B, S, N_HEADS, V_DIM)
        lam = (jnp.exp(jnp.sum(lambda_q1[l].astype(jnp.float32) * lambda_k1[l].astype(jnp.float32)))
               - jnp.exp(jnp.sum(lambda_q2[l].astype(jnp.float32) * lambda_k2[l].astype(jnp.float32)))
               + lambda_init)
        attn_out = diff_attention(q, k, v, q_norm_g[l], k_norm_g[l], rel_bias, lam, subln_g[l], lambda_init)
        rnn_out = rg_lru_branch(xr, gr, conv_w[l], conv_b[l], w_rg_a[l], b_rg_a[l],
                                w_rg_x[l], b_rg_x[l], lru_lambda[l])
        y_attn = jnp.einsum('bse,ed->bsd', attn_out, w_proj_attn[l])
        y_rnn = jnp.einsum('bse,ed->bsd', rnn_out, w_proj_rnn[l])
        merged = jax.nn.sigmoid(g_attn) * y_attn + jax.nn.sigmoid(g_rnn) * y_rnn
        x = x + jnp.einsum('bsd,de->bse', merged, w_out[l])
        h2 = rmsnorm(x, norm_mlp_g[l])
        up = jnp.square(jax.nn.relu(jnp.einsum('bsd,df->bsf', h2, w_up[l])))
        x = x + jnp.einsum('bsf,fd->bsd', up, w_down[l])
    return x
```

```cpp
#include <hip/hip_runtime.h>
#include <cstdio>
#include <cstdint>

constexpr int BATCH = 8, SEQ = 4096, DM = 1024, M = BATCH * SEQ, NH = 8, FF = 4096, NIN = 7168;
constexpr float EPS = 1e-6f;
constexpr float LOG2E = 1.4426950408889634f;
constexpr float C2 = 0.125f * LOG2E;
constexpr float LAMBDA_INIT = 0.2f;

namespace pg8 {
#define PG8_LAS __attribute__((address_space(3)))
typedef unsigned short bf16_t;
typedef short bf16x8 __attribute__((ext_vector_type(8)));
typedef float f32x4 __attribute__((ext_vector_type(4)));
typedef unsigned u32x4 __attribute__((ext_vector_type(4)));
typedef unsigned u32x2 __attribute__((ext_vector_type(2)));
constexpr int BM = 256, BK = 64, HALF = 128, HTB = HALF * BK * 2, STAGE_BYTES = 8 * HTB, NXCD = 8, WGM = 8;

__host__ __device__ __forceinline__ int lds_byte(int r, int c) { const int st = (r >> 4) * 2 + (c >> 5), rr = r & 15, cc = c & 31, ob = rr * 64 + cc * 2; return st * 1024 + (ob ^ (((ob >> 9) & 1) << 5)); }
__host__ __device__ __forceinline__ void stage_rc(int b, int& R, int& C) { const int st = b / 1024, sb = b % 1024, swz = sb ^ (((sb >> 9) & 1) << 5); R = (st >> 1) * 16 + swz / 64; C = (st & 1) * 32 + (swz % 64) / 2; }
__host__ __device__ __forceinline__ int perm32(int rho) { const int n = rho >> 4, i = rho & 15; return 8 * (i >> 2) + 4 * n + (i & 3); }

struct Unit { int pm, pn, z; };
struct Gemm { const bf16_t* A; const bf16_t* Bt; const bf16_t* A2; const bf16_t* Bt2; size_t abs, abs2; int M, N, K; };

struct StaticOrder {
    int nM, nN, nwg, G, c; bool rot = false;
    __host__ __device__ void init(int M_, int N_, int G_, int c_) { nM = M_ / BM; nN = N_ / BM; nwg = nM * nN; G = G_; c = c_; }
    __host__ __device__ bool next(int i, Unit& u) const {
        const long L = (long)i * G + c; if (L >= nwg) return false;
        int wgid = (int)L; { const int q = nwg / NXCD, r = nwg % NXCD, xcd = wgid % NXCD, off = wgid / NXCD; wgid = (xcd < r ? xcd * (q + 1) : r * (q + 1) + (xcd - r) * q) + off; }
        const int nig = WGM * nN, gid = wgid / nig, fm = gid * WGM, gsz = (nM - fm) < WGM ? (nM - fm) : WGM;
        u.pm = fm + ((wgid % nig) % gsz); u.pn = (wgid % nig) / gsz; u.z = 0;
        if (rot) { const int slot = u.pn & 3, t = u.pn >> 2; u.pn = ((t + 2 * slot) % 7) * 4 + slot; }
        return true;
    }
};
struct PairOrder {
    StaticOrder base;
    __host__ __device__ void init(int M_, int N_, int G_, int c_) { base.init(M_, N_, G_, c_); }
    __host__ __device__ bool next(int i, Unit& u) const { if (!base.next(i >> 1, u)) return false; u.z = i & 1; return true; }
};

__device__ __forceinline__ unsigned cvt_pk_bf16(float lo, float hi) { unsigned r; asm volatile("v_cvt_pk_bf16_f32 %0, %1, %2" : "=v"(r) : "v"(lo), "v"(hi)); return r; }
__device__ __forceinline__ float bf_lo(unsigned w) { return __uint_as_float(w << 16); }
__device__ __forceinline__ float bf_hi(unsigned w) { return __uint_as_float(w & 0xffff0000u); }
__device__ __forceinline__ float sigmoid_f(float x) { return __builtin_amdgcn_rcpf(1.0f + __builtin_amdgcn_exp2f(-LOG2E * x)); }
__device__ __forceinline__ float gelu_tanh_f(float x) { const float u = x * (1.0f + 0.044715f * x * x); return x * sigmoid_f(1.5957691216057308f * u); }


struct EpiIn {
    static constexpr bool PERM = true, KEEP = false;
    bf16_t* out0; size_t bse, sect_stride; const float* qg; const float* kg;
    __device__ __forceinline__ void operator()(f32x4 (&acc)[2][2][4][2], const Unit& u, int wr, int wc, int fr, int fq) const {
        const int type = u.pn >> 2, colt = (u.pn & 3) * BM;
        bf16_t* base = out0 + (size_t)(u.pm >> 4) * bse + (size_t)type * sect_stride;
        const int row0 = (u.pm & 15) * BM + wr * 64 + fr;
        if (type <= 1) {
            const float* g = type == 0 ? qg : kg; const float sc = type == 0 ? C2 : 1.0f;
            f32x4 gv[2][2];
#pragma unroll
            for (int bj = 0; bj < 2; ++bj)
#pragma unroll
                for (int n = 0; n < 2; ++n) gv[bj][n] = *(const f32x4*)(g + 32 * bj + 8 * fq + 4 * n) * sc;
            const int col0 = colt + 64 * wc + 8 * fq;
#pragma unroll
            for (int ai = 0; ai < 2; ++ai)
#pragma unroll
                for (int m = 0; m < 4; ++m) { bf16_t* rowp = base + (size_t)(row0 + ai * HALF + m * 16) * DM + col0;
                    float ss = 0.f;
#pragma unroll
                    for (int bj = 0; bj < 2; ++bj)
#pragma unroll
                        for (int n = 0; n < 2; ++n) { const f32x4 x = acc[ai][bj][m][n]; ss += (x[0] * x[0] + x[1] * x[1]) + (x[2] * x[2] + x[3] * x[3]); }
                    ss += __shfl_xor(ss, 16); ss += __shfl_xor(ss, 32);
                    const float rinv = __builtin_amdgcn_rsqf(ss * (1.0f / 64.0f) + EPS);
#pragma unroll
                    for (int bj = 0; bj < 2; ++bj) { const f32x4 v0 = acc[ai][bj][m][0] * rinv * gv[bj][0], v1 = acc[ai][bj][m][1] * rinv * gv[bj][1];
                        u32x4 w; w.x = cvt_pk_bf16(v0[0], v0[1]); w.y = cvt_pk_bf16(v0[2], v0[3]); w.z = cvt_pk_bf16(v1[0], v1[1]); w.w = cvt_pk_bf16(v1[2], v1[3]);
                        __builtin_nontemporal_store(w, (u32x4*)(rowp + 32 * bj)); } }
        } else {
            const int col0 = colt + wc * 32 + 8 * fq;
#pragma unroll
            for (int ai = 0; ai < 2; ++ai)
#pragma unroll
                for (int m = 0; m < 4; ++m) { bf16_t* rowp = base + (size_t)(row0 + ai * HALF + m * 16) * DM + col0;
#pragma unroll
                    for (int bj = 0; bj < 2; ++bj) { f32x4 v0 = acc[ai][bj][m][0], v1 = acc[ai][bj][m][1];
                        if (type == 4) {
#pragma unroll
                            for (int i = 0; i < 4; ++i) { v0[i] = gelu_tanh_f(v0[i]); v1[i] = gelu_tanh_f(v1[i]); }
                        } else if (type == 5) {
#pragma unroll
                            for (int i = 0; i < 4; ++i) { v0[i] = 1.0f + __builtin_amdgcn_exp2f(-LOG2E * v0[i]); v1[i] = 1.0f + __builtin_amdgcn_exp2f(-LOG2E * v1[i]); }
                        } else if (type == 6) {
#pragma unroll
                            for (int i = 0; i < 4; ++i) { v0[i] = sigmoid_f(v0[i]); v1[i] = sigmoid_f(v1[i]); }
                        }
                        u32x4 w; w.x = cvt_pk_bf16(v0[0], v0[1]); w.y = cvt_pk_bf16(v0[2], v0[3]); w.z = cvt_pk_bf16(v1[0], v1[1]); w.w = cvt_pk_bf16(v1[2], v1[3]);
                        __builtin_nontemporal_store(w, (u32x4*)(rowp + bj * HALF)); } }
        }
    }
};

struct EpiMerge {
    static constexpr bool PERM = true, KEEP = true;
    const bf16_t* __restrict__ sga; const bf16_t* __restrict__ sgr; bf16_t* __restrict__ out; size_t bse;
    __device__ __forceinline__ void operator()(f32x4 (&acc)[2][2][4][2], const Unit& u, int wr, int wc, int fr, int fq) const {
        const int row0 = (u.pm & 15) * BM + wr * 64 + fr, col0 = u.pn * BM + wc * 32 + 8 * fq; const size_t boff = (size_t)(u.pm >> 4) * bse;
#pragma unroll
        for (int ai = 0; ai < 2; ++ai) {
            u32x4 gr[4][2], ga[4][2];
#pragma unroll
            for (int m = 0; m < 4; ++m)
#pragma unroll
                for (int bj = 0; bj < 2; ++bj) { const size_t off = boff + (size_t)(row0 + ai * HALF + m * 16) * DM + col0 + bj * HALF;
                    gr[m][bj] = *(const u32x4*)(sgr + off); if (u.z == 0) ga[m][bj] = *(const u32x4*)(sga + off); }
#pragma unroll
            for (int m = 0; m < 4; ++m)
#pragma unroll
                for (int bj = 0; bj < 2; ++bj) { const size_t off = boff + (size_t)(row0 + ai * HALF + m * 16) * DM + col0 + bj * HALF;
                    const u32x4 g = gr[m][bj];
                    const f32x4 r0 = (f32x4){bf_lo(g.x), bf_hi(g.x), bf_lo(g.y), bf_hi(g.y)}, r1 = (f32x4){bf_lo(g.z), bf_hi(g.z), bf_lo(g.w), bf_hi(g.w)};
                    if (u.z == 0) {
                        const u32x4 h = ga[m][bj];
                        const f32x4 a0 = (f32x4){bf_lo(h.x), bf_hi(h.x), bf_lo(h.y), bf_hi(h.y)}, a1 = (f32x4){bf_lo(h.z), bf_hi(h.z), bf_lo(h.w), bf_hi(h.w)};
#pragma unroll
                        for (int i = 0; i < 4; ++i) { acc[ai][bj][m][0][i] *= __builtin_amdgcn_rcpf(a0[i] * r0[i]); acc[ai][bj][m][1][i] *= __builtin_amdgcn_rcpf(a1[i] * r1[i]); }
                    } else {
                        const f32x4 v0 = acc[ai][bj][m][0] * r0, v1 = acc[ai][bj][m][1] * r1;
                        u32x4 w; w.x = cvt_pk_bf16(v0[0], v0[1]); w.y = cvt_pk_bf16(v0[2], v0[3]); w.z = cvt_pk_bf16(v1[0], v1[1]); w.w = cvt_pk_bf16(v1[2], v1[3]);
                        *(u32x4*)(out + off) = w;
                    } } }
    }
};

struct EpiX1 {
    static constexpr bool PERM = true, KEEP = false;
    const float* __restrict__ x; bf16_t* __restrict__ xn2; float* __restrict__ rowsq; size_t bse;
    __device__ __forceinline__ void operator()(f32x4 (&acc)[2][2][4][2], const Unit& u, int wr, int wc, int fr, int fq) const {
        const int row0 = u.pm * BM + wr * 64 + fr, col0 = u.pn * BM + wc * 32 + 8 * fq;
#pragma unroll
        for (int ai = 0; ai < 2; ++ai) {
            f32x4 xv[4][2][2];
#pragma unroll
            for (int m = 0; m < 4; ++m)
#pragma unroll
                for (int bj = 0; bj < 2; ++bj)
#pragma unroll
                    for (int n = 0; n < 2; ++n) xv[m][bj][n] = *(const f32x4*)(x + (size_t)(row0 + ai * HALF + m * 16) * DM + col0 + bj * HALF + n * 4);
#pragma unroll
            for (int m = 0; m < 4; ++m) { const int row = row0 + ai * HALF + m * 16; float ss = 0.f;
                bf16_t* rowp = xn2 + (size_t)(u.pm >> 4) * bse + (size_t)(row & 4095) * DM + col0;
#pragma unroll
                for (int bj = 0; bj < 2; ++bj) { const f32x4 o0 = xv[m][bj][0] + acc[ai][bj][m][0], o1 = xv[m][bj][1] + acc[ai][bj][m][1];
                    ss += ((o0[0] * o0[0] + o0[1] * o0[1]) + (o0[2] * o0[2] + o0[3] * o0[3])) + ((o1[0] * o1[0] + o1[1] * o1[1]) + (o1[2] * o1[2] + o1[3] * o1[3]));
                    u32x4 w; w.x = cvt_pk_bf16(o0[0], o0[1]); w.y = cvt_pk_bf16(o0[2], o0[3]); w.z = cvt_pk_bf16(o1[0], o1[1]); w.w = cvt_pk_bf16(o1[2], o1[3]);
                    *(u32x4*)(rowp + bj * HALF) = w; }
                ss += __shfl_xor(ss, 16); ss += __shfl_xor(ss, 32);
                if (fq == 0) atomicAdd(rowsq + row, ss); } }
    }
};

struct EpiUp {
    static constexpr bool PERM = true, KEEP = false;
    const float* __restrict__ rowsq; bf16_t* __restrict__ out; size_t bse;
    mutable float rinv_c[2][4]; mutable int pm_c;
    __device__ __forceinline__ void operator()(f32x4 (&acc)[2][2][4][2], const Unit& u, int wr, int wc, int fr, int fq) const {
        const int row0 = u.pm * BM + wr * 64 + fr, col0 = u.pn * BM + wc * 32 + 8 * fq;
        if (u.pm != pm_c) {
            float rs[2][4];
#pragma unroll
            for (int ai = 0; ai < 2; ++ai)
#pragma unroll
                for (int m = 0; m < 4; ++m) rs[ai][m] = rowsq[row0 + ai * HALF + m * 16];
#pragma unroll
            for (int ai = 0; ai < 2; ++ai)
#pragma unroll
                for (int m = 0; m < 4; ++m) rinv_c[ai][m] = __builtin_amdgcn_rsqf(rs[ai][m] * (1.0f / DM) + EPS);
            pm_c = u.pm; }
#pragma unroll
        for (int ai = 0; ai < 2; ++ai)
#pragma unroll
            for (int m = 0; m < 4; ++m) { const int row = row0 + ai * HALF + m * 16; const float rinv = rinv_c[ai][m];
                bf16_t* rowp = out + (size_t)(u.pm >> 4) * bse + (size_t)(row & 4095) * FF + col0;
#pragma unroll
                for (int bj = 0; bj < 2; ++bj) { f32x4 v0 = acc[ai][bj][m][0] * rinv, v1 = acc[ai][bj][m][1] * rinv;
#pragma unroll
                    for (int i = 0; i < 4; ++i) { const float a = fmaxf(v0[i], 0.f), b = fmaxf(v1[i], 0.f); v0[i] = a * a; v1[i] = b * b; }
                    u32x4 w; w.x = cvt_pk_bf16(v0[0], v0[1]); w.y = cvt_pk_bf16(v0[2], v0[3]); w.z = cvt_pk_bf16(v1[0], v1[1]); w.w = cvt_pk_bf16(v1[2], v1[3]);
                    __builtin_nontemporal_store(w, (u32x4*)(rowp + bj * HALF)); } }
    }
};

struct EpiDown {
    static constexpr bool PERM = true, KEEP = false;
    const bf16_t* __restrict__ xn2; float* __restrict__ dst; size_t bse;
    __device__ __forceinline__ void operator()(f32x4 (&acc)[2][2][4][2], const Unit& u, int wr, int wc, int fr, int fq) const {
        const int row0 = u.pm * BM + wr * 64 + fr, col0 = u.pn * BM + wc * 32 + 8 * fq;
        u32x4 rv[2][4][2];
#pragma unroll
        for (int ai = 0; ai < 2; ++ai)
#pragma unroll
            for (int m = 0; m < 4; ++m)
#pragma unroll
                for (int bj = 0; bj < 2; ++bj) rv[ai][m][bj] = *(const u32x4*)(xn2 + (size_t)(u.pm >> 4) * bse + (size_t)((row0 + ai * HALF + m * 16) & 4095) * DM + col0 + bj * HALF);
#pragma unroll
        for (int ai = 0; ai < 2; ++ai)
#pragma unroll
            for (int m = 0; m < 4; ++m)
#pragma unroll
                for (int bj = 0; bj < 2; ++bj) { const u32x4 g = rv[ai][m][bj]; float* rowp = dst + (size_t)(row0 + ai * HALF + m * 16) * DM + col0 + bj * HALF;
                    const f32x4 r0 = (f32x4){bf_lo(g.x), bf_hi(g.x), bf_lo(g.y), bf_hi(g.y)}, r1 = (f32x4){bf_lo(g.z), bf_hi(g.z), bf_lo(g.w), bf_hi(g.w)};
                    *(f32x4*)(rowp) = r0 + acc[ai][bj][m][0]; *(f32x4*)(rowp + 4) = r1 + acc[ai][bj][m][1]; }
    }
};

template <class Epi, class Sched, bool ALIGN_EPI = false, bool SP2 = false>
__device__ __forceinline__ void gemm_phase(PG8_LAS unsigned char* lds, const Gemm g, const Sched& S, const Epi& E) {
    const int tid = threadIdx.x, wid = __builtin_amdgcn_readfirstlane(tid >> 6), lane = tid & 63, wr = wid >> 2, wc = wid & 3, fr = lane & 15, fq = lane >> 4;
    const int K = g.K, nt = K / BK;
    unsigned voffA[2], voffB[2];
#pragma unroll
    for (int i = 0; i < 2; ++i) { int R, C; stage_rc(tid * 16 + i * 8192, R, C); const int Rb = Epi::PERM ? ((R & ~31) + perm32(R & 31)) : R;
        voffA[i] = (unsigned)(R * K + C) * 2u; voffB[i] = (unsigned)(Rb * K + C) * 2u; }
    const size_t kstep = (size_t)(BK * 2);
    const size_t hstep = (size_t)HALF * K * 2;
    const size_t tstep = 2 * hstep;
    const unsigned ldsw = (unsigned)wid * 1024u;
    const int aoff = lds_byte(wr * 64 + fr, fq * 8), boff = lds_byte(wc * 32 + fr, fq * 8);
#define PG8_SA(b, h) (((b) * 2 + (h)) * HTB)
#define PG8_SB(b, h) ((4 + (b) * 2 + (h)) * HTB)
#define PG8_STAGE(bufoff, gbase, voff) do { _Pragma("unroll") for (int _i = 0; _i < 2; ++_i) \
        __builtin_amdgcn_global_load_lds((const unsigned*)((const char*)(gbase) + (voff)[_i]), (PG8_LAS unsigned*)(lds + (bufoff) + ldsw + _i * 8192), 16, 0, 0); } while (0)
#define PG8_LDA(dst, b, h) do { _Pragma("unroll") for (int m = 0; m < 4; ++m) _Pragma("unroll") for (int k = 0; k < 2; ++k) dst[m][k] = *(const PG8_LAS bf16x8*)(lds + PG8_SA(b, h) + aoff + m * 2048 + k * 1024); } while (0)
#define PG8_LDB(dst, b, h) do { _Pragma("unroll") for (int n = 0; n < 2; ++n) _Pragma("unroll") for (int k = 0; k < 2; ++k) dst[n][k] = *(const PG8_LAS bf16x8*)(lds + PG8_SB(b, h) + boff + n * 2048 + k * 1024); } while (0)
#define PG8_MMA(ai, bj, At, Bt) do { __builtin_amdgcn_s_setprio(1); _Pragma("unroll") for (int m = 0; m < 4; ++m) _Pragma("unroll") for (int n = 0; n < 2; ++n) _Pragma("unroll") for (int k = 0; k < 2; ++k) \
        acc[ai][bj][m][n] = __builtin_amdgcn_mfma_f32_16x16x32_bf16(Bt[n][k], At[m][k], acc[ai][bj][m][n], 0, 0, 0); __builtin_amdgcn_s_setprio(0); } while (0)
#define PG8_WAIT_V(n) asm volatile("s_waitcnt vmcnt(" #n ")" ::: "memory")
#define PG8_WAIT_L(n) asm volatile("s_waitcnt lgkmcnt(" #n ")" ::: "memory")
#define PG8_BAR __builtin_amdgcn_s_barrier()
#define PG8_SCHED __builtin_amdgcn_sched_barrier(0)
    Unit cur, nxt; int ui = 0;
    if (!S.next(0, cur)) return;
    f32x4 acc[2][2][4][2];
#pragma unroll
    for (int a = 0; a < 2; ++a)
#pragma unroll
        for (int b = 0; b < 2; ++b)
#pragma unroll
            for (int m = 0; m < 4; ++m)
#pragma unroll
                for (int n = 0; n < 2; ++n) acc[a][b][m][n] = (f32x4){0.f, 0.f, 0.f, 0.f};
    bf16x8 At[4][2], B0[2][2], B1[2][2];
#define PG8_ABASE(u) ((const char*)((u).z ? g.A2 : g.A) + (size_t)((u).pm >> 4) * ((u).z ? g.abs2 : g.abs) + (size_t)((u).pm & 15) * tstep)
    const char* cA = PG8_ABASE(cur); const char* cB = (const char*)(cur.z ? g.Bt2 : g.Bt) + (size_t)cur.pn * tstep;
    if constexpr (SP2) {
        PG8_STAGE(PG8_SB(0, 0), cB, voffB); PG8_STAGE(PG8_SB(0, 1), cB + hstep, voffB); PG8_STAGE(PG8_SA(0, 0), cA, voffA); PG8_STAGE(PG8_SA(0, 1), cA + hstep, voffA);
        if (wr == 1) PG8_BAR;
        PG8_WAIT_V(2); PG8_BAR;
        PG8_STAGE(PG8_SB(1, 0), cB + kstep, voffB); PG8_STAGE(PG8_SA(1, 0), cA + kstep, voffA); PG8_STAGE(PG8_SB(1, 1), cB + hstep + kstep, voffB);
        PG8_WAIT_V(6); PG8_BAR;
    } else {
        PG8_STAGE(PG8_SB(0, 0), cB, voffB); PG8_STAGE(PG8_SA(0, 0), cA, voffA); PG8_STAGE(PG8_SB(0, 1), cB + hstep, voffB); PG8_STAGE(PG8_SA(0, 1), cA + hstep, voffA);
        if (wr == 1) PG8_BAR;
        PG8_WAIT_V(4); PG8_BAR;
        PG8_STAGE(PG8_SB(1, 0), cB + kstep, voffB); PG8_STAGE(PG8_SA(1, 0), cA + kstep, voffA); PG8_STAGE(PG8_SB(1, 1), cB + hstep + kstep, voffB);
        PG8_WAIT_V(6); PG8_BAR;
    }
    for (;;) {
        const bool has_next = S.next(ui + 1, nxt);
        const char* nA = has_next ? PG8_ABASE(nxt) : cA; const char* nB = has_next ? (const char*)(nxt.z ? g.Bt2 : g.Bt) + (size_t)nxt.pn * tstep : cB;
        for (int t = 0; t < nt; t += 2) {
            const bool last = (t == nt - 2);
            const char* a1 = cA + (size_t)(t + 1) * kstep;
            const char* a2 = last ? nA : cA + (size_t)(t + 2) * kstep; const char* b2 = last ? nB : cB + (size_t)(t + 2) * kstep;
            const char* a3 = a2 + kstep; const char* b3 = b2 + kstep;
            if constexpr (SP2) {
            PG8_LDB(B0, 0, 0); PG8_LDB(B1, 0, 1); PG8_SCHED; PG8_LDA(At, 0, 0); PG8_STAGE(PG8_SA(1, 1), a1 + hstep, voffA);
            PG8_WAIT_V(8); PG8_WAIT_L(0); PG8_BAR; PG8_MMA(0, 0, At, B0); PG8_MMA(0, 1, At, B1); PG8_BAR; PG8_SCHED;
            PG8_LDA(At, 0, 1); PG8_STAGE(PG8_SB(0, 0), b2, voffB); PG8_STAGE(PG8_SB(0, 1), b2 + hstep, voffB); PG8_STAGE(PG8_SA(0, 0), a2, voffA);
            PG8_WAIT_V(8); PG8_WAIT_L(0); PG8_BAR; PG8_MMA(1, 0, At, B0); PG8_MMA(1, 1, At, B1); PG8_BAR; PG8_SCHED;
            PG8_LDB(B0, 1, 0); PG8_LDB(B1, 1, 1); PG8_SCHED; PG8_LDA(At, 1, 0); PG8_STAGE(PG8_SA(0, 1), a2 + hstep, voffA);
            PG8_WAIT_V(8); PG8_WAIT_L(0); PG8_BAR; PG8_MMA(0, 0, At, B0); PG8_MMA(0, 1, At, B1); PG8_BAR; PG8_SCHED;
            PG8_LDA(At, 1, 1); PG8_STAGE(PG8_SB(1, 0), b3, voffB); PG8_STAGE(PG8_SB(1, 1), b3 + hstep, voffB); PG8_STAGE(PG8_SA(1, 0), a3, voffA);
            PG8_WAIT_V(8); PG8_WAIT_L(0); PG8_BAR; PG8_MMA(1, 0, At, B0); PG8_MMA(1, 1, At, B1); PG8_BAR; PG8_SCHED;
            } else {
            PG8_LDB(B0, 0, 0); PG8_SCHED; PG8_LDA(At, 0, 0); PG8_STAGE(PG8_SA(1, 1), a1 + hstep, voffA);
            PG8_WAIT_L(8); PG8_BAR; PG8_WAIT_L(0); PG8_MMA(0, 0, At, B0); PG8_BAR; PG8_SCHED;
            PG8_LDB(B1, 0, 1); PG8_STAGE(PG8_SB(0, 0), b2, voffB);
            PG8_BAR; PG8_WAIT_L(0); PG8_MMA(0, 1, At, B1); PG8_BAR;
            PG8_LDA(At, 0, 1); PG8_STAGE(PG8_SA(0, 0), a2, voffA);
            PG8_BAR; PG8_WAIT_L(0); PG8_MMA(1, 0, At, B0); PG8_BAR; PG8_SCHED;
            PG8_STAGE(PG8_SB(0, 1), b2 + hstep, voffB);
            PG8_WAIT_V(6); PG8_BAR; PG8_MMA(1, 1, At, B1); PG8_BAR;
            PG8_LDB(B0, 1, 0); PG8_SCHED; PG8_LDA(At, 1, 0); PG8_STAGE(PG8_SA(0, 1), a2 + hstep, voffA);
            PG8_WAIT_L(8); PG8_BAR; PG8_WAIT_L(0); PG8_MMA(0, 0, At, B0); PG8_BAR; PG8_SCHED;
            PG8_LDB(B1, 1, 1); PG8_STAGE(PG8_SB(1, 0), b3, voffB);
            PG8_BAR; PG8_WAIT_L(0); PG8_MMA(0, 1, At, B1); PG8_BAR;
            PG8_LDA(At, 1, 1); PG8_STAGE(PG8_SA(1, 0), a3, voffA);
            PG8_BAR; PG8_WAIT_L(0); PG8_MMA(1, 0, At, B0); PG8_BAR; PG8_SCHED;
            PG8_STAGE(PG8_SB(1, 1), b3 + hstep, voffB);
            PG8_WAIT_V(6); PG8_BAR; PG8_MMA(1, 1, At, B1); PG8_BAR;
            }
        }
        if constexpr (ALIGN_EPI) { if (wr == 0) PG8_BAR; }
        E(acc, cur, wr, wc, fr, fq);
        if (!has_next) break;
        if (!(Epi::KEEP && cur.z == 0)) {
#pragma unroll
        for (int a = 0; a < 2; ++a)
#pragma unroll
            for (int b = 0; b < 2; ++b)
#pragma unroll
                for (int m = 0; m < 4; ++m)
#pragma unroll
                    for (int n = 0; n < 2; ++n) acc[a][b][m][n] = (f32x4){0.f, 0.f, 0.f, 0.f};
        }
        cur = nxt; cA = nA; cB = nB; ++ui;
        if constexpr (ALIGN_EPI) { if (wr == 1) PG8_BAR; }
    }
    PG8_WAIT_V(0);
    if constexpr (!ALIGN_EPI) { if (wr == 0) PG8_BAR; }
    PG8_BAR;
#undef PG8_ABASE
#undef PG8_SA
#undef PG8_SB
#undef PG8_STAGE
#undef PG8_LDA
#undef PG8_LDB
#undef PG8_MMA
#undef PG8_WAIT_V
#undef PG8_WAIT_L
#undef PG8_BAR
#undef PG8_SCHED
}
}

#ifndef PG8_SP2
#define PG8_SP2 true
#endif
#ifndef PG8_ALIGN
#define PG8_ALIGN true
#endif

#define GAS __attribute__((address_space(1)))
#define LAS __attribute__((address_space(3)))
typedef unsigned short bf16;
typedef unsigned v4u __attribute__((ext_vector_type(4)));
typedef unsigned v2u __attribute__((ext_vector_type(2)));
typedef float f32x4 __attribute__((ext_vector_type(4)));
typedef float f32x16 __attribute__((ext_vector_type(16)));
typedef short bf16x8 __attribute__((ext_vector_type(8)));
typedef short s16x4 __attribute__((ext_vector_type(4)));
typedef GAS unsigned gu32;
#define RLX_AGENT __ATOMIC_RELAXED, __HIP_MEMORY_SCOPE_AGENT
#define LDS_WAIT() asm volatile("s_waitcnt lgkmcnt(0)" ::: "memory")
#define VM_WAIT() asm volatile("s_waitcnt vmcnt(0)" ::: "memory")
typedef float f32x2_c __attribute__((ext_vector_type(2))); typedef __bf16 bf16x2_c __attribute__((ext_vector_type(2)));
__device__ __forceinline__ unsigned pk2(float lo, float hi) { f32x2_c v = {lo, hi}; bf16x2_c b = __builtin_convertvector(v, bf16x2_c); return __builtin_bit_cast(unsigned, b); }
__device__ __forceinline__ unsigned f2bf(float f) { return pk2(f, 0.f) & 0xffffu; }
__device__ __forceinline__ float bflo(unsigned w) { return __uint_as_float(w << 16); }
__device__ __forceinline__ float bfhi(unsigned w) { return __uint_as_float(w & 0xffff0000u); }

constexpr size_t MiB = 1u << 20;
constexpr size_t WS_CTL = 0, CTL_ZERO_BYTES = 2 * MiB;
constexpr size_t WS_ROWSQ = 512 * 1024;
constexpr size_t WS_WIN = 2 * MiB, WS_WPA = 16 * MiB, WS_WPR = 18 * MiB, WS_WOUT = 20 * MiB, WS_WUP = 22 * MiB, WS_WDN = 30 * MiB;
constexpr size_t WS_WGA = 38 * MiB, WS_WGX = WS_WGA + 256 * 1024;
constexpr size_t WS_B0 = 48 * MiB, BST = 56 * MiB, SEC = 8 * MiB;
constexpr size_t O_Q = 0, O_K = SEC, O_V = 2 * SEC, O_XR = 3 * SEC, O_GG = 4 * SEC, O_SGA = 5 * SEC, O_SGR = 6 * SEC;
constexpr size_t O_XN2 = O_Q;
constexpr size_t O_MERGED = O_SGR;
constexpr size_t O_UP = O_K;
constexpr size_t WS_END = WS_B0 + 8 * BST;
constexpr size_t DBS = 16 * MiB, DO_R = 8 * MiB;
constexpr int CW_BAR = 4096, CW_QBAR = 262144;

constexpr int RING_OFF = 0, RING_BYTES = 131072;
constexpr int LDSCTL_OFF = 160768, MISC_OFF = LDSCTL_OFF + 320;
constexpr int LDS_BYTES = 163840;

#define XB_TMO      128
#define XB_XCNT(j)  (256  + 64 * (j))
#define XB_XSUB(j)  (1280 + 64 * (j))
#define XB_XGEN(j)  (2304 + 64 * (j))
#define XB_TOP      3328
#define XB_TOPGEN   3392
#define XCD_BAR_WORDS 3456
#define XB_SPIN_CAP (1u << 18)
__device__ __forceinline__ unsigned xb_ld(unsigned* p)              { return __hip_atomic_load(p, __ATOMIC_RELAXED, __HIP_MEMORY_SCOPE_AGENT); }
__device__ __forceinline__ unsigned xb_add(unsigned* p, unsigned v) { return __hip_atomic_fetch_add(p, v, __ATOMIC_RELAXED, __HIP_MEMORY_SCOPE_AGENT); }
__device__ __forceinline__ unsigned xb_xcc_id() { return (unsigned)__builtin_amdgcn_s_getreg((3 << 11) | 20) & 0xFu; }
#define XB_SPIN(cond, bar) do { unsigned _sp = 0; while (cond) { __builtin_amdgcn_s_sleep(1); \
    if ((++_sp & 255u) == 0u) { if (xb_ld(&(bar)[XB_TMO])) break; if (_sp > XB_SPIN_CAP) { atomicAdd(&(bar)[XB_TMO], 1u); break; } } } } while (0)
struct XcdBarrier { unsigned* bar; unsigned x; volatile LAS unsigned* st; unsigned members; };
__device__ __forceinline__ XcdBarrier xcd_barrier_post(unsigned* bar, volatile LAS unsigned* st, unsigned members) {
    XcdBarrier b; b.bar = bar; b.x = xb_xcc_id(); b.st = st; b.members = members;
    if (threadIdx.x == 0) (void)xb_add(&bar[XB_XCNT(b.x)], 1u);
    return b;
}
__device__ __forceinline__ void xcd_barrier_complete(unsigned* bar, unsigned x, unsigned G, unsigned& nloc, unsigned& nx) {
    unsigned sum, cnt, mine, sp = 0u;
    for (;;) {
        sum = 0u; cnt = 0u; mine = 0u;
#pragma unroll
        for (unsigned j = 0; j < 16; ++j) { const unsigned c = xb_ld(&bar[XB_XCNT(j)]); sum += c; cnt += (c > 0u) ? 1u : 0u; mine = (j == x) ? c : mine; }
        if (sum == G) break;
        __builtin_amdgcn_s_sleep(1);
        if ((++sp & 255u) == 0u) { if (xb_ld(&bar[XB_TMO])) break; if (sp > XB_SPIN_CAP) { atomicAdd(&bar[XB_TMO], 1u); break; } }
    }
    nloc = mine > 0u ? mine : 1u; nx = cnt > 0u ? cnt : 1u;
}
__device__ __forceinline__ void xcd_barrier(const XcdBarrier& b) {
    asm volatile("s_waitcnt vmcnt(0)" ::: "memory");
    __syncthreads();
    if (threadIdx.x == 0) {
        unsigned* bar = b.bar;
        __builtin_amdgcn_s_waitcnt(0);
        unsigned nloc = b.st[0], nx = b.st[1];
        if (nloc == 0u) { xcd_barrier_complete(bar, b.x, b.members, nloc, nx); b.st[0] = nloc; b.st[1] = nx; }
        const unsigned old = xb_add(&bar[XB_XSUB(b.x)], 1u);
        const unsigned gen = old / nloc;
        if (old + 1u == (gen + 1u) * nloc) {
            __builtin_amdgcn_fence(__ATOMIC_RELEASE, "agent");
            asm volatile("s_waitcnt vmcnt(0)" ::: "memory");
            const unsigned og = xb_add(&bar[XB_TOP], 1u);
            const unsigned tg = og / nx;
            if (og + 1u == (tg + 1u) * nx) xb_add(&bar[XB_TOPGEN], 1u);
            else XB_SPIN(xb_ld(&bar[XB_TOPGEN]) == tg, bar);
            __builtin_amdgcn_fence(__ATOMIC_ACQUIRE, "agent");
            xb_add(&bar[XB_XGEN(b.x)], 1u);
            asm volatile("s_waitcnt vmcnt(0)" ::: "memory");
        } else {
            XB_SPIN(xb_ld(&bar[XB_XGEN(b.x)]) == gen, bar);
            __builtin_amdgcn_fence(__ATOMIC_ACQUIRE, "agent");
            asm volatile("s_waitcnt vmcnt(0)" ::: "memory");
        }
    }
    __syncthreads();
}

constexpr int NWAVES = 8;
struct Frame {
    LAS unsigned char* lds;
    volatile LAS unsigned* MISC;
    gu32* ctl;
    int tid, lane, wave, vcu, G;
    const float* in[24];
    float* out; unsigned char* ws;
};

__device__ __forceinline__ float wave_sum(float v) {
#pragma unroll
    for (int o = 1; o < 64; o <<= 1) v += __shfl_xor(v, o);
    return v;
}

__device__ __forceinline__ void p0_transpose_item(const float* W, int K, int N, bf16* WT, LAS float* scr, int item, int lane, const float* kscale, bool remap) {
    const int nblk = N / 32, kb = item / nblk, nb = item % nblk, k0 = 64 * kb, n0 = 32 * nb;
    f32x4 v[8];
#pragma unroll
    for (int i = 0; i < 8; ++i) v[i] = __builtin_nontemporal_load((const GAS f32x4*)(W + (size_t)(k0 + 8 * i + (lane >> 3)) * N + n0 + 4 * (lane & 7)));
#pragma unroll
    for (int i = 0; i < 8; ++i) { const int kk = 8 * i + (lane >> 3); f32x4 x = v[i]; if (kscale) x = x * kscale[k0 + kk];
        LAS float* d = scr + kk * 33 + 4 * (lane & 7); d[0] = x.x; d[1] = x.y; d[2] = x.z; d[3] = x.w; }
    LDS_WAIT(); asm volatile("" ::: "memory");
    int slot0 = n0;
    if (remap && n0 < 2048) { const int ls = n0 & 255, wc = ls >> 6, bj = (ls >> 5) & 1; slot0 = (n0 & ~255) + 128 * bj + 32 * wc; }
    const int c = lane & 7;
#pragma unroll
    for (int j = 0; j < 4; ++j) { const int n = (lane >> 3) + 8 * j; const LAS float* sp = scr + (8 * c) * 33 + n;
        v4u o; o.x = pk2(sp[0 * 33], sp[1 * 33]); o.y = pk2(sp[2 * 33], sp[3 * 33]); o.z = pk2(sp[4 * 33], sp[5 * 33]); o.w = pk2(sp[6 * 33], sp[7 * 33]);
        *(GAS v4u*)(WT + (size_t)(slot0 + n) * K + k0 + 8 * c) = o; }
    LDS_WAIT(); asm volatile("" ::: "memory");
}
__device__ __forceinline__ void rms_rows4_to_bf16(int lane, const float* xrow, const float* g, bf16* orow) {
    f32x4 v[4][4];
#pragma unroll
    for (int r = 0; r < 4; ++r)
#pragma unroll
        for (int j = 0; j < 4; ++j) v[r][j] = __builtin_nontemporal_load((const GAS f32x4*)(xrow + (size_t)r * DM) + lane + 64 * j);
    f32x4 gg[4];
#pragma unroll
    for (int j = 0; j < 4; ++j) gg[j] = *((const GAS f32x4*)g + lane + 64 * j);
#pragma unroll
    for (int r = 0; r < 4; ++r) { float s = 0.f;
#pragma unroll
        for (int j = 0; j < 4; ++j) s += (v[r][j].x * v[r][j].x + v[r][j].y * v[r][j].y) + (v[r][j].z * v[r][j].z + v[r][j].w * v[r][j].w);
        const float rinv = __builtin_amdgcn_rsqf(wave_sum(s) * (1.f / DM) + EPS);
        GAS unsigned long long* o8 = (GAS unsigned long long*)(orow + (size_t)r * DM) + lane;
#pragma unroll
        for (int j = 0; j < 4; ++j) { const f32x4 y = v[r][j] * rinv * gg[j]; o8[64 * j] = (unsigned long long)pk2(y.x, y.y) | ((unsigned long long)pk2(y.z, y.w) << 32); } }
}
__device__ __forceinline__ void p0_prologue(Frame& F, const int parts = 3) {
    LAS float* scr = (LAS float*)(F.lds + RING_OFF + F.wave * 16384);
    const int gw = F.vcu * NWAVES + F.wave, NGW = F.G * NWAVES;
    bf16* Win_t = (bf16*)(F.ws + WS_WIN); bf16* Wpa_t = (bf16*)(F.ws + WS_WPA); bf16* Wpr_t = (bf16*)(F.ws + WS_WPR); bf16* Wout_t = (bf16*)(F.ws + WS_WOUT);
    bf16* Wup_t = (bf16*)(F.ws + WS_WUP); bf16* Wdn_t = (bf16*)(F.ws + WS_WDN); bf16* Wga_t = (bf16*)(F.ws + WS_WGA); bf16* Wgx_t = (bf16*)(F.ws + WS_WGX);
    constexpr int I_IN = (DM / 64) * (NIN / 32), I_SQ = (DM / 64) * (DM / 32), I_UP = (DM / 64) * (FF / 32), I_DN = (FF / 64) * (DM / 32), I_G = 2 * 4;
    constexpr int NITEMS = I_IN + 3 * I_SQ + I_UP + I_DN + 16 * I_G;
    if (parts & 1) for (int it = gw; it < NITEMS; it += NGW) {
        int r = it;
        if (r < I_IN) { p0_transpose_item(F.in[2], DM, NIN, Win_t, scr, r, F.lane, nullptr, true); continue; } r -= I_IN;
        if (r < I_SQ) { p0_transpose_item(F.in[17], DM, DM, Wpa_t, scr, r, F.lane, nullptr, false); continue; } r -= I_SQ;
        if (r < I_SQ) { p0_transpose_item(F.in[18], DM, DM, Wpr_t, scr, r, F.lane, nullptr, false); continue; } r -= I_SQ;
        if (r < I_SQ) { p0_transpose_item(F.in[19], DM, DM, Wout_t, scr, r, F.lane, nullptr, false); continue; } r -= I_SQ;
        if (r < I_UP) { p0_transpose_item(F.in[21], DM, FF, Wup_t, scr, r, F.lane, F.in[20], false); continue; } r -= I_UP;
        if (r < I_DN) { p0_transpose_item(F.in[22], FF, DM, Wdn_t, scr, r, F.lane, nullptr, false); continue; } r -= I_DN;
        { const int blk = r / I_G, sub = r % I_G;
          const float* W = (blk < 8 ? F.in[12] : F.in[14]) + (size_t)(blk & 7) * 16384; bf16* WT = (blk < 8 ? Wga_t : Wgx_t) + (size_t)(blk & 7) * 16384;
          p0_transpose_item(W, 128, 128, WT, scr, sub, F.lane, nullptr, false); }
    }
    bf16* XN = (bf16*)F.out;
    if (parts & 2) for (int m = 4 * gw; m < M; m += 4 * NGW) rms_rows4_to_bf16(F.lane, F.in[0] + (size_t)m * DM, F.in[1], XN + (size_t)(m >> 12) * (DBS / 2) + (size_t)(m & 4095) * DM);
}

namespace lru {
constexpr int TS = 128, NST = SEQ / TS, NITEMS = BATCH * 8 * 4;
constexpr int XS = 272;
constexpr int IMG_BYTES = TS * XS;
constexpr int HS = 80;
constexpr int L_IMG = 0, L_HL = 2 * IMG_BYTES, L_SUM = L_HL + 2 * TS * HS, L_END = L_SUM + 2 * 1024;
static_assert(L_END <= RING_BYTES, "lru lds");
typedef float f32x4_t __attribute__((ext_vector_type(4)));
__device__ __forceinline__ float shfl_from(float x, int src) { return __uint_as_float((unsigned)__builtin_amdgcn_ds_bpermute(src << 2, (int)__float_as_uint(x))); }

__device__ __forceinline__ void item(Frame& F, int it) {
    const int b = it >> 5, blk = (it >> 2) & 7, oc = it & 3;
    const int tid = F.tid, lane = F.lane, w = F.wave;
    const bf16* XR = (const bf16*)(F.ws + WS_B0 + (size_t)b * BST + O_XR); const bf16* GG = (const bf16*)(F.ws + WS_B0 + (size_t)b * BST + O_GG);
    bf16* R = (bf16*)((unsigned char*)F.out + (size_t)b * DBS + DO_R);
    LAS unsigned char* L = F.lds + RING_OFF;
    const int rbw = w & 3, cbw = w >> 2, f = lane & 15, kq = lane >> 4;
    const int cib = oc * 32 + cbw * 16 + f, gch = blk * 128 + cib;
    const float nba = -LOG2E * F.in[13][gch], nbx = -LOG2E * F.in[15][gch];
    const float sp8 = 8.0f * log1pf(expf(-F.in[16][gch]));
    const float k_a = -sp8 * LOG2E;
    bf16x8 Ba[4], Bx[4];
    { const bf16* wa = (const bf16*)(F.ws + WS_WGA) + (size_t)blk * 16384 + cib * 128 + 8 * kq; const bf16* wx = (const bf16*)(F.ws + WS_WGX) + (size_t)blk * 16384 + cib * 128 + 8 * kq;
#pragma unroll
      for (int ks = 0; ks < 4; ++ks) { Ba[ks] = *(const bf16x8*)(wa + ks * 32); Bx[ks] = *(const bf16x8*)(wx + ks * 32); } }
    const int cg = tid & 15, tq = tid >> 4, cch = blk * 128 + cg * 8;
    f32x2_c cw2[4][4], cb2[4];
#pragma unroll
    for (int p = 0; p < 4; ++p) { cb2[p] = (f32x2_c){F.in[11][cch + 2 * p], F.in[11][cch + 2 * p + 1]};
#pragma unroll
        for (int j = 0; j < 4; ++j) cw2[j][p] = (f32x2_c){F.in[10][j * DM + cch + 2 * p], F.in[10][j * DM + cch + 2 * p + 1]}; }
    const bf16* xrp = XR + cch;
    const int ott = tid >> 2, opart = tid & 3;
    const size_t ooff = (size_t)ott * DM + blk * 128 + oc * 32 + opart * 8;
    v4u xv[7];
#define LRU_LOAD(t0_) do { _Pragma("unroll") for (int j = 0; j < 7; ++j) { const int tr = (t0_) + 4 * tq - 3 + j; xv[j] = tr >= 0 ? *(const v4u*)(xrp + (size_t)tr * DM) : (v4u){0u, 0u, 0u, 0u}; } } while (0)
    LRU_LOAD(0);
    float hc = 0.f;
    float av[2][4], bv[2][4], Ae[2], He[2], At[2], Ht[2];
    float pav[2][4], pbv[2][4], pAe[2], pHe[2], pAt[2], pHt[2];
    v4u gv0 = (v4u){0u, 0u, 0u, 0u}, gv1 = gv0, gv2 = gv0;
#pragma unroll 1
    for (int st = 0; st < NST + 2; ++st) {
        const int t0 = st * TS;
        LAS unsigned char* img = L + L_IMG + (st & 1) * IMG_BYTES;
        if (st < NST) {
            f32x2_c fr[7][4];
#pragma unroll
            for (int j = 0; j < 7; ++j) { fr[j][0] = (f32x2_c){bflo(xv[j].x), bfhi(xv[j].x)}; fr[j][1] = (f32x2_c){bflo(xv[j].y), bfhi(xv[j].y)}; fr[j][2] = (f32x2_c){bflo(xv[j].z), bfhi(xv[j].z)}; fr[j][3] = (f32x2_c){bflo(xv[j].w), bfhi(xv[j].w)}; }
#pragma unroll
            for (int tk = 0; tk < 4; ++tk) { f32x2_c xc[4];
#pragma unroll
                for (int p = 0; p < 4; ++p) xc[p] = __builtin_elementwise_fma(cw2[3][p], fr[tk + 3][p], __builtin_elementwise_fma(cw2[2][p], fr[tk + 2][p], __builtin_elementwise_fma(cw2[1][p], fr[tk + 1][p], __builtin_elementwise_fma(cw2[0][p], fr[tk][p], cb2[p]))));
                v4u pw; pw.x = pk2(xc[0].x, xc[0].y); pw.y = pk2(xc[1].x, xc[1].y); pw.z = pk2(xc[2].x, xc[2].y); pw.w = pk2(xc[3].x, xc[3].y);
                *(LAS v4u*)(img + (4 * tq + tk) * XS + cg * 16) = pw; }
            if (st + 1 < NST) LRU_LOAD(t0 + TS);
            gv0 = *(const v4u*)(GG + ooff + (size_t)t0 * DM);
        }
        LDS_WAIT(); __builtin_amdgcn_s_barrier(); asm volatile("" ::: "memory");
        if (st >= 2) {
            const v4u hv = *(const LAS v4u*)(L + L_HL + (st & 1) * (TS * HS) + ott * HS + opart * 16);
            v4u o; o.x = pk2(bflo(hv.x) * bflo(gv2.x), bfhi(hv.x) * bfhi(gv2.x)); o.y = pk2(bflo(hv.y) * bflo(gv2.y), bfhi(hv.y) * bfhi(gv2.y));
            o.z = pk2(bflo(hv.z) * bflo(gv2.z), bfhi(hv.z) * bfhi(gv2.z)); o.w = pk2(bflo(hv.w) * bflo(gv2.w), bfhi(hv.w) * bfhi(gv2.w));
            *(v4u*)(R + ooff + (size_t)(t0 - 2 * TS) * DM) = o;
        }
        if (st >= 1 && st <= NST) {
            const LAS float* sum = (const LAS float*)(L + L_SUM + ((st - 1) & 1) * 1024);
            LAS unsigned char* hl = L + L_HL + ((st - 1) & 1) * (TS * HS);
            float cin = hc;
#pragma unroll
            for (int rb = 0; rb < 4; ++rb) { const float Aw = sum[((cbw * 4 + rb) * 16 + f) * 2], Hw = sum[((cbw * 4 + rb) * 16 + f) * 2 + 1];
                hc = Aw * hc + Hw; if (rb < rbw) cin = hc; }
#pragma unroll
            for (int sg = 0; sg < 2; ++sg) { float hh = pAe[sg] * cin + pHe[sg];
#pragma unroll
                for (int rg = 0; rg < 4; ++rg) { hh = pav[sg][rg] * hh + pbv[sg][rg];
                    *(LAS unsigned short*)(hl + (32 * rbw + 16 * sg + 4 * kq + rg) * HS + (cbw * 16 + f) * 2) = (unsigned short)f2bf(hh); }
                cin = pAt[sg] * cin + pHt[sg]; }
        }
        if (st < NST) {
            LAS float* sum = (LAS float*)(L + L_SUM + (st & 1) * 1024);
            f32x4_t gaa[2], gxx[2]; bf16x8 af[2][4];
#pragma unroll
            for (int sg = 0; sg < 2; ++sg) { gaa[sg] = (f32x4_t){0.f, 0.f, 0.f, 0.f}; gxx[sg] = (f32x4_t){0.f, 0.f, 0.f, 0.f};
#pragma unroll
                for (int ks = 0; ks < 4; ++ks) af[sg][ks] = *(const LAS bf16x8*)(img + (32 * rbw + 16 * sg + f) * XS + (ks * 32 + 8 * kq) * 2); }
#pragma unroll
            for (int ks = 0; ks < 4; ++ks)
#pragma unroll
                for (int sg = 0; sg < 2; ++sg) { gaa[sg] = __builtin_amdgcn_mfma_f32_16x16x32_bf16(af[sg][ks], Ba[ks], gaa[sg], 0, 0, 0); gxx[sg] = __builtin_amdgcn_mfma_f32_16x16x32_bf16(af[sg][ks], Bx[ks], gxx[sg], 0, 0, 0); }
#pragma unroll
            for (int sg = 0; sg < 2; ++sg) { const int row0 = 32 * rbw + 16 * sg;
                const f32x4_t ga = gaa[sg], gx = gxx[sg];
#pragma unroll
                for (int rg = 0; rg < 4; ++rg) {
                    const float xc = __uint_as_float((unsigned)(*(const LAS unsigned short*)(img + (row0 + 4 * kq + rg) * XS + cib * 2)) << 16);
                    const float r = __builtin_amdgcn_rcpf(1.0f + __builtin_amdgcn_exp2f(__builtin_fmaf(ga[rg], -LOG2E, nba)));
                    const float iv = __builtin_amdgcn_rcpf(1.0f + __builtin_amdgcn_exp2f(__builtin_fmaf(gx[rg], -LOG2E, nbx)));
                    const float a = __builtin_amdgcn_exp2f(r * k_a);
                    const float m1 = __builtin_fmaf(-a, a, 1.0f);
                    av[sg][rg] = a; bv[sg][rg] = __builtin_amdgcn_sqrtf(m1) * (iv * xc); }
                float A = av[sg][0], H = bv[sg][0];
#pragma unroll
                for (int j = 1; j < 4; ++j) { H = av[sg][j] * H + bv[sg][j]; A *= av[sg][j]; }
                { const auto pa = __builtin_amdgcn_permlane16_swap(__float_as_uint(A), __float_as_uint(A), false, false), ph = __builtin_amdgcn_permlane16_swap(__float_as_uint(H), __float_as_uint(H), false, false);
                  if (kq & 1) { const float A1 = __uint_as_float(pa[0]), H1 = __uint_as_float(ph[0]); H = A * H1 + H; A = A * A1; } }
                { const auto pa = __builtin_amdgcn_permlane16_swap(__float_as_uint(A), __float_as_uint(A), false, false), ph = __builtin_amdgcn_permlane16_swap(__float_as_uint(H), __float_as_uint(H), false, false);
                  const auto qa = __builtin_amdgcn_permlane32_swap(pa[1], pa[1], false, false), qh = __builtin_amdgcn_permlane32_swap(ph[1], ph[1], false, false);
                  if (kq >= 2) { const float A2 = __uint_as_float(qa[0]), H2 = __uint_as_float(qh[0]); H = A * H2 + H; A = A * A2; } }
                { const auto pa = __builtin_amdgcn_permlane16_swap(__float_as_uint(A), __float_as_uint(A), false, false), ph = __builtin_amdgcn_permlane16_swap(__float_as_uint(H), __float_as_uint(H), false, false);
                  const auto qa = __builtin_amdgcn_permlane32_swap(pa[1], pa[1], false, false), qh = __builtin_amdgcn_permlane32_swap(ph[1], ph[1], false, false);
                  At[sg] = __uint_as_float(qa[1]); Ht[sg] = __uint_as_float(qh[1]);
                  Ae[sg] = (kq & 1) ? __uint_as_float(pa[0]) : __uint_as_float(qa[0]); He[sg] = (kq & 1) ? __uint_as_float(ph[0]) : __uint_as_float(qh[0]);
                  if (kq == 0) { Ae[sg] = 1.f; He[sg] = 0.f; } } }
            if (kq == 0) { sum[((cbw * 4 + rbw) * 16 + f) * 2] = At[1] * At[0]; sum[((cbw * 4 + rbw) * 16 + f) * 2 + 1] = At[1] * Ht[0] + Ht[1]; }
        }
#pragma unroll
        for (int sg = 0; sg < 2; ++sg) { pAe[sg] = Ae[sg]; pHe[sg] = He[sg]; pAt[sg] = At[sg]; pHt[sg] = Ht[sg];
#pragma unroll
            for (int rg = 0; rg < 4; ++rg) { pav[sg][rg] = av[sg][rg]; pbv[sg][rg] = bv[sg][rg]; } }
        gv2 = gv1; gv1 = gv0;
    }
#undef LRU_LOAD
    LDS_WAIT(); __builtin_amdgcn_s_barrier(); asm volatile("" ::: "memory");
}
__device__ __forceinline__ void phase(Frame& F) { for (int it = F.vcu; it < NITEMS; it += F.G) item(F, it); }
}

namespace att {
constexpr int SLOTK = 8192, SLOTV = 16384;
constexpr int L_K = 0, L_V = 4 * SLOTK, L_STG = L_V + 3 * SLOTV, L_WS = L_STG + 8 * 8192, L_TAB = L_WS + 8 * 256, TABN = 704, TREL = 447, L_END = L_TAB + 4 * TABN * 4;
static_assert(L_END <= LDSCTL_OFF, "attention lds");
typedef LAS const char* lds_cptr;
typedef short v4i16_t __attribute__((ext_vector_type(4)));
typedef float f32x2_t __attribute__((ext_vector_type(2))); typedef __bf16 bf16x2_t __attribute__((ext_vector_type(2)));
#define SBAR() __builtin_amdgcn_sched_barrier(0)
#define PIN(x) asm volatile("" : "+v"(x))
#define MF(a, b, c) __builtin_amdgcn_mfma_f32_32x32x16_bf16(a, b, c, 0, 0, 0)
#define WAIT_BAR(N) asm volatile("s_waitcnt vmcnt(" #N ") lgkmcnt(0)\n\ts_barrier" ::: "memory")
__device__ __forceinline__ int crow(int r, int hi) { return (r & 3) + 8 * (r >> 2) + 4 * hi; }
__device__ __forceinline__ void glds16(const void* gsrc, unsigned lds_dst) { unsigned keep;
    asm volatile("s_mov_b32 %0, m0\n\ts_mov_b32 m0, %2\n\ts_nop 0\n\tglobal_load_lds_dwordx4 %1, off\n\ts_mov_b32 m0, %0" : "=&s"(keep) : "v"(gsrc), "s"(lds_dst) : "memory"); }
__device__ __forceinline__ unsigned cvtpk_s(float lo, float hi) { f32x2_t v = {lo, hi}; bf16x2_t b = __builtin_convertvector(v, bf16x2_t); return __builtin_bit_cast(unsigned, b); }
__device__ __forceinline__ void kload2(bf16x8* kf, lds_cptr kp, int d0) { kf[2 * d0] = *(const LAS bf16x8*)(kp + d0 * 2048); kf[2 * d0 + 1] = *(const LAS bf16x8*)(kp + d0 * 2048 + 512); }
__device__ __forceinline__ s16x4 vtr(lds_cptr p) { return __builtin_bit_cast(s16x4, __builtin_amdgcn_ds_read_tr16_b64_v4i16((LAS v4i16_t*)p)); }
__device__ __forceinline__ int bucket_of(int n) {
    if (n < 16) return n;
    int bk = 16;
    bk += (n >= 19); bk += (n >= 21); bk += (n >= 24); bk += (n >= 27); bk += (n >= 31); bk += (n >= 35); bk += (n >= 40); bk += (n >= 46);
    bk += (n >= 52); bk += (n >= 59); bk += (n >= 67); bk += (n >= 77); bk += (n >= 87); bk += (n >= 99); bk += (n >= 113);
    return bk;
}
__device__ __forceinline__ void bias_init(f32x16& p0, f32x16& p1, const LAS char* bp) {
    typedef float f32x4_t __attribute__((ext_vector_type(4)));
    const f32x4_t a0 = *(const LAS f32x4_t*)(bp), a1 = *(const LAS f32x4_t*)(bp + 32), a2 = *(const LAS f32x4_t*)(bp + 64), a3 = *(const LAS f32x4_t*)(bp + 96);
    const f32x4_t b0 = *(const LAS f32x4_t*)(bp + 128), b1 = *(const LAS f32x4_t*)(bp + 160), b2 = *(const LAS f32x4_t*)(bp + 192), b3 = *(const LAS f32x4_t*)(bp + 224);
    p0 = (f32x16){a0[0], a0[1], a0[2], a0[3], a1[0], a1[1], a1[2], a1[3], a2[0], a2[1], a2[2], a2[3], a3[0], a3[1], a3[2], a3[3]};
    p1 = (f32x16){b0[0], b0[1], b0[2], b0[3], b1[0], b1[1], b1[2], b1[3], b2[0], b2[1], b2[2], b2[3], b3[0], b3[1], b3[2], b3[3]};
}
__device__ __forceinline__ void pv(f32x16* o, int vb, bf16x8 pa0, bf16x8 pa1, bf16x8 pa2, bf16x8 pa3) {
#pragma unroll
    for (int d0 = 0; d0 < 4; ++d0) { s16x4 lo[4], hi[4];
#pragma unroll
        for (int ks = 0; ks < 4; ++ks) {
            asm volatile("ds_read_b64_tr_b16 %0,%1 offset:%c2" : "=&v"(lo[ks]) : "v"(vb), "i"(d0 * 4096 + ks * 1024) : "memory");
            asm volatile("ds_read_b64_tr_b16 %0,%1 offset:%c2" : "=&v"(hi[ks]) : "v"(vb), "i"(d0 * 4096 + ks * 1024 + 512) : "memory"); }
        asm volatile("s_waitcnt lgkmcnt(0)" ::: "memory"); SBAR();
#define PK(k) (bf16x8){lo[k][0], lo[k][1], lo[k][2], lo[k][3], hi[k][0], hi[k][1], hi[k][2], hi[k][3]}
        o[d0] = MF(pa0, PK(0), o[d0]); o[d0] = MF(pa1, PK(1), o[d0]); o[d0] = MF(pa2, PK(2), o[d0]); o[d0] = MF(pa3, PK(3), o[d0]);
#undef PK
    }
}

struct PassSrc { const bf16* ksrc; const bf16* vsrc; const bf16* qw; };
__device__ __forceinline__ PassSrc pass_src(int b, int h, int qb, int c, const bf16* Q, const bf16* K, const bf16* V, int lane, int wid) {
    const size_t bb = (size_t)b * (BST / 2); PassSrc p;
    p.ksrc = K + bb + h * 128 + c * 64 + (long)lane * DM + wid * 8;
    p.vsrc = V + bb + h * 128 + (long)(16 * (wid & 3) + (lane >> 2)) * DM + (wid >> 2) * 32 + (lane & 3) * 8;
    p.qw = Q + bb + (long)(qb * 256 + wid * 32 + (lane & 31)) * DM + h * 128 + c * 64 + (lane >> 5) * 8;
    return p;
}
#define ATT_DMA_K(src, t) glds16((src) + (long)(t) * 64 * DM, (unsigned)__builtin_amdgcn_readfirstlane(kdst + ((t) & 3) * SLOTK))
#define ATT_DMA_V(src, t, voff) do { glds16((src) + (long)(t) * 64 * DM, (unsigned)__builtin_amdgcn_readfirstlane(vdst + (voff))); \
                                     glds16((src) + (long)(t) * 64 * DM + 64, (unsigned)__builtin_amdgcn_readfirstlane(vdst + (voff) + 8192)); } while (0)

__device__ __forceinline__ void apass(int b, int h, int qb, int c, bool first, bool has_next, const PassSrc nx, const bf16* K, const bf16* V, bf16* O, LAS unsigned char* lds, float lam,
                                      const float* rel_bias, const float* subln_g, bf16x8 (&qr)[4], int& sl_prev, int& sl_cur, int& sl_next) {
    const int tid = threadIdx.x, lane = tid & 63, r32 = lane & 31, hi = lane >> 5; const int wid = __builtin_amdgcn_readfirstlane(tid >> 6);
    const int q0 = qb * 256, NT = 4 * qb + 4;
    const unsigned lds0 = (unsigned)(uintptr_t)lds;
    LAS float* wsf = (LAS float*)(lds + L_WS) + wid * 64;
    LAS float* tab = (LAS float*)(lds + L_TAB);
    LAS unsigned short* stg = (LAS unsigned short*)(lds + L_STG) + wid * 4096;
    const int qpos = q0 + wid * 32 + r32;
    const int vb0 = (int)(lds0 + L_V) + ((lane >> 4) & 1) * 32 + (lane & 3) * 8 + (4 * hi + ((lane & 15) >> 2)) * 64;
    const lds_cptr vp0 = (lds_cptr)(lds + L_V) + ((lane >> 4) & 1) * 32 + (lane & 3) * 8 + (4 * hi + ((lane & 15) >> 2)) * 64;
    const lds_cptr kp0 = (lds_cptr)(lds + L_K) + hi * 1024 + r32 * 16;
    const f32x16 ZERO = f32x16{};
    const unsigned kdst = lds0 + L_K + wid * 1024, vdst = lds0 + L_V + wid * 1024;
#define ROT() do { sl_prev = sl_cur; sl_cur = sl_next; sl_next = (sl_next == 2 * SLOTV) ? 0 : sl_next + SLOTV; } while (0)
    if (!first) ROT();
    if (c == 0) {
        const float b31 = rel_bias[31 * NH + h];
        for (int j = tid; j < TABN; j += 512) { const int rel = TREL - j;
            const float v = rel < 0 ? -INFINITY : (rel < 113 ? (rel_bias[bucket_of(rel) * NH + h] - b31) * LOG2E : 0.f);
#pragma unroll
            for (int cc = 0; cc < 4; ++cc) if (j - cc >= 0) tab[cc * TABN + j - cc] = v; }
        asm volatile("s_waitcnt lgkmcnt(0)\n\ts_barrier" ::: "memory"); }
    const int cpy = (3 - qpos) & 3;
    const LAS char* tabl = (const LAS char*)tab + cpy * (TABN * 4) + 4 * (TREL - qpos + 4 * hi - cpy);
    {
        const PassSrc cu = pass_src(b, h, qb, c, nullptr, K, V, lane, wid);
        const bf16* ksrc = cu.ksrc; const bf16* vsrc = cu.vsrc;
#define DMA_K(t) ATT_DMA_K(ksrc, t)
#define DMA_V(t, voff) ATT_DMA_V(vsrc, t, voff)
        f32x16 o[4];
#pragma unroll
        for (int d0 = 0; d0 < 4; ++d0) o[d0] = f32x16{};
        float l_reg = 0.f;
        f32x16 pA0, pA1, pB0, pB1; bf16x8 kf[8]; s16x4 vlo[3], vhi[3]; v4u pw0, pw1, pw2, pw3;
#define EX(v) __builtin_amdgcn_exp2f(v)
#define PKW(P, i) cvtpk_s(P[i], P[(i) + 1])
#pragma unroll
        for (int d0 = 0; d0 < 4; ++d0) kload2(kf, kp0, d0);
        if (NT <= 6) { bias_init(pA0, pA1, tabl); pA0 = MF(kf[0], qr[0], pA0); pA1 = MF(kf[1], qr[0], pA1); }
        else { pA0 = MF(kf[0], qr[0], ZERO); pA1 = MF(kf[1], qr[0], ZERO); }
        pA0 = MF(kf[2], qr[1], pA0); pA1 = MF(kf[3], qr[1], pA1);
        pA0 = MF(kf[4], qr[2], pA0); pA1 = MF(kf[5], qr[2], pA1); pA0 = MF(kf[6], qr[3], pA0); pA1 = MF(kf[7], qr[3], pA1);
#pragma unroll
        for (int r = 0; r < 16; ++r) { pA0[r] = EX(pA0[r]); pA1[r] = EX(pA1[r]); }
        asm volatile("s_waitcnt lgkmcnt(0)\n\ts_barrier" ::: "memory");
        DMA_K(3); DMA_V(1, sl_next); ROT();
        kload2(kf, kp0 + SLOTK, 0); kload2(kf, kp0 + SLOTK, 1);
#define PAF(k) __builtin_bit_cast(bf16x8, pw##k)
#define VFR(i) (bf16x8){vlo[(i) % 3][0], vlo[(i) % 3][1], vlo[(i) % 3][2], vlo[(i) % 3][3], vhi[(i) % 3][0], vhi[(i) % 3][1], vhi[(i) % 3][2], vhi[(i) % 3][3]}
#define VRD(i) do { vlo[(i) % 3] = vtr(vp_ + (((i) & 3) * 4096 + ((i) >> 2) * 1024)); vhi[(i) % 3] = vtr(vp_ + (((i) & 3) * 4096 + ((i) >> 2) * 1024 + 512)); } while (0)
#define KRD(G, d0) do { if (G) { kload2(kf, knx_, d0); } } while (0)
#define GAPA(MFX, a0, a1, a2, a3, W0, W1, PW) do { MFX; sacc += a0; sacc += a1; sacc += a2; sacc += a3; W0; W1; PIN(PW); PIN(sacc); SBAR(); } while (0)
#define GAPB(MFX, X, i) do { MFX; X[i] = EX(X[i]); X[(i) + 1] = EX(X[(i) + 1]); PIN(X); SBAR(); } while (0)
#define STEP(C0, C1, P0, P1, t, BANDF, GK, GV, GL) do { SBAR(); \
    const lds_cptr vp_ = vp0 + sl_prev; const lds_cptr kcu_ = kp0 + ((t) & 3) * SLOTK; const lds_cptr knx_ = kp0 + (((t) + 1) & 3) * SLOTK; \
    if (BANDF) { bias_init(C0, C1, tabl + (t) * 256); } \
    kload2(kf, kcu_, 2); kload2(kf, kcu_, 3); \
    float sacc = P0[0] + P0[1]; SBAR(); \
    if (BANDF) { GAPA(C0 = MF(kf[0], qr[0], C0),   P0[2], P0[3], P0[4], P0[5],     pw0[0] = PKW(P0, 0),  pw0[1] = PKW(P0, 2),  pw0); \
                 GAPA(C1 = MF(kf[1], qr[0], C1),   P0[6], P0[7], P0[8], P0[9],     pw0[2] = PKW(P0, 4),  pw0[3] = PKW(P0, 6),  pw0); } \
    else       { GAPA(C0 = MF(kf[0], qr[0], ZERO), P0[2], P0[3], P0[4], P0[5],     pw0[0] = PKW(P0, 0),  pw0[1] = PKW(P0, 2),  pw0); \
                 GAPA(C1 = MF(kf[1], qr[0], ZERO), P0[6], P0[7], P0[8], P0[9],     pw0[2] = PKW(P0, 4),  pw0[3] = PKW(P0, 6),  pw0); } \
    GAPA(C0 = MF(kf[2], qr[1], C0),   P0[10], P0[11], P0[12], P0[13], pw1[0] = PKW(P0, 8),  pw1[1] = PKW(P0, 10), pw1); \
    GAPA(C1 = MF(kf[3], qr[1], C1),   P0[14], P0[15], P1[0], P1[1],   pw1[2] = PKW(P0, 12), pw1[3] = PKW(P0, 14), pw1); \
    GAPA(C0 = MF(kf[4], qr[2], C0),   P1[2], P1[3], P1[4], P1[5],     pw2[0] = PKW(P1, 0),  pw2[1] = PKW(P1, 2),  pw2); \
    GAPA(C1 = MF(kf[5], qr[2], C1),   P1[6], P1[7], P1[8], P1[9],     pw2[2] = PKW(P1, 4),  pw2[3] = PKW(P1, 6),  pw2); \
    VRD(0); SBAR(); GAPA(C0 = MF(kf[6], qr[3], C0), P1[10], P1[11], P1[12], P1[13], pw3[0] = PKW(P1, 8),  pw3[1] = PKW(P1, 10), pw3); \
    VRD(1); SBAR(); GAPA(C1 = MF(kf[7], qr[3], C1), P1[14], P1[15], 0.f, 0.f,       pw3[2] = PKW(P1, 12), pw3[3] = PKW(P1, 14), pw3); \
    l_reg += sacc; \
    if (GK) DMA_K((t) + 3); if (GV) DMA_V((t) + 1, sl_next); \
    SBAR(); \
    VRD(2);              SBAR(); GAPB(o[0] = MF(PAF(0), VFR(0),  o[0]), C0, 0); \
    VRD(3);              SBAR(); GAPB(o[1] = MF(PAF(0), VFR(1),  o[1]), C0, 2); \
    VRD(4);              SBAR(); GAPB(o[2] = MF(PAF(0), VFR(2),  o[2]), C0, 4); \
    VRD(5);              SBAR(); GAPB(o[3] = MF(PAF(0), VFR(3),  o[3]), C0, 6); \
    VRD(6);              SBAR(); GAPB(o[0] = MF(PAF(1), VFR(4),  o[0]), C0, 8); \
    VRD(7);  KRD(GL, 0); SBAR(); GAPB(o[1] = MF(PAF(1), VFR(5),  o[1]), C0, 10); \
    VRD(8);              SBAR(); GAPB(o[2] = MF(PAF(1), VFR(6),  o[2]), C0, 12); \
    VRD(9);              SBAR(); GAPB(o[3] = MF(PAF(1), VFR(7),  o[3]), C0, 14); \
    VRD(10);             SBAR(); GAPB(o[0] = MF(PAF(2), VFR(8),  o[0]), C1, 0); \
    VRD(11);             SBAR(); GAPB(o[1] = MF(PAF(2), VFR(9),  o[1]), C1, 2); \
    VRD(12);             SBAR(); GAPB(o[2] = MF(PAF(2), VFR(10), o[2]), C1, 4); \
    VRD(13); KRD(GL, 1); SBAR(); GAPB(o[3] = MF(PAF(2), VFR(11), o[3]), C1, 6); \
    VRD(14);             SBAR(); GAPB(o[0] = MF(PAF(3), VFR(12), o[0]), C1, 8); \
    VRD(15);             SBAR(); GAPB(o[1] = MF(PAF(3), VFR(13), o[1]), C1, 10); \
                                 GAPB(o[2] = MF(PAF(3), VFR(14), o[2]), C1, 12); \
                                 GAPB(o[3] = MF(PAF(3), VFR(15), o[3]), C1, 14); \
    } while (0)
        int t = 1;
        for (; t + 7 < NT; t += 2) {
            STEP(pB0, pB1, pA0, pA1, t, false, true, true, true);     WAIT_BAR(3); ROT();
            STEP(pA0, pA1, pB0, pB1, t + 1, false, true, true, true); WAIT_BAR(3); ROT();
        }
#define ENDW(tt) do { if ((tt) + 3 < NT) { WAIT_BAR(3); } else if ((tt) + 2 < NT) { WAIT_BAR(2); } else { WAIT_BAR(0); } } while (0)
        for (; t + 1 < NT; t += 2) {
            STEP(pB0, pB1, pA0, pA1, t, true, (t + 3 < NT), (t + 1 < NT), (t + 1 < NT));     ENDW(t);     ROT();
            STEP(pA0, pA1, pB0, pB1, t + 1, true, (t + 4 < NT), (t + 2 < NT), (t + 2 < NT)); ENDW(t + 1); ROT();
        }
        if (has_next) { ATT_DMA_K(nx.ksrc, 0); ATT_DMA_V(nx.vsrc, 0, sl_next); ATT_DMA_K(nx.ksrc, 1); ATT_DMA_K(nx.ksrc, 2); }
        STEP(pB0, pB1, pA0, pA1, NT - 1, true, false, false, false);
        { float sacc = pB0[0] + pB0[1];
#pragma unroll
          for (int r = 2; r < 16; ++r) sacc += pB0[r];
#pragma unroll
          for (int r = 0; r < 16; ++r) sacc += pB1[r];
          l_reg += sacc;
          pw0 = (v4u){PKW(pB0, 0), PKW(pB0, 2), PKW(pB0, 4), PKW(pB0, 6)}; pw1 = (v4u){PKW(pB0, 8), PKW(pB0, 10), PKW(pB0, 12), PKW(pB0, 14)};
          pw2 = (v4u){PKW(pB1, 0), PKW(pB1, 2), PKW(pB1, 4), PKW(pB1, 6)}; pw3 = (v4u){PKW(pB1, 8), PKW(pB1, 10), PKW(pB1, 12), PKW(pB1, 14)};
          SBAR(); pv(o, vb0 + sl_cur, PAF(0), PAF(1), PAF(2), PAF(3)); }
#undef GAPA
#undef GAPB
        if (has_next) {
#pragma unroll
            for (int d0 = 0; d0 < 4; ++d0) qr[d0] = *reinterpret_cast<const bf16x8*>(nx.qw + d0 * 16);
        }
#undef DMA_K
#undef DMA_V
#undef EX
#undef PKW
#undef PAF
#undef VFR
#undef VRD
#undef KRD
#undef STEP
#undef ENDW
        { auto rr = __builtin_amdgcn_permlane32_swap(__float_as_uint(l_reg), __float_as_uint(l_reg), false, false); l_reg = __uint_as_float(rr[0]) + __uint_as_float(rr[1]); }
        int le = lane; asm volatile("" : "+v"(le));
        const int r32e = le & 31, hie = le >> 5;
        if (hie == 0) wsf[32 + r32e] = __builtin_amdgcn_rcpf(l_reg);
        LDS_WAIT();
        float rli[16];
#pragma unroll
        for (int r = 0; r < 16; ++r) rli[r] = wsf[32 + crow(r, hie)];
        LDS_WAIT();
        LAS v4u* stp = (LAS v4u*)stg + le;
        if (c == 0) {
#pragma unroll
            for (int j = 0; j < 8; ++j) { const int d0 = j >> 1, rb = (j & 1) * 8; v4u w;
                w.x = pk2(o[d0][rb + 0] * rli[rb + 0], o[d0][rb + 1] * rli[rb + 1]); w.y = pk2(o[d0][rb + 2] * rli[rb + 2], o[d0][rb + 3] * rli[rb + 3]);
                w.z = pk2(o[d0][rb + 4] * rli[rb + 4], o[d0][rb + 5] * rli[rb + 5]); w.w = pk2(o[d0][rb + 6] * rli[rb + 6], o[d0][rb + 7] * rli[rb + 7]);
                stp[64 * j] = w; }
            LDS_WAIT();
        } else {
            v4u s0[8];
#pragma unroll
            for (int j = 0; j < 8; ++j) s0[j] = stp[64 * j];
            float gsub[4];
#pragma unroll
            for (int d0 = 0; d0 < 4; ++d0) gsub[d0] = subln_g[d0 * 32 + r32e] * (1.0f - LAMBDA_INIT);
            LDS_WAIT();
            LAS unsigned short* stl = stg + (4 * hie) * 128 + r32e;
#pragma unroll
            for (int r = 0; r < 16; ++r) { float dv[4]; float ss = 0.f;
#pragma unroll
                for (int d0 = 0; d0 < 4; ++d0) { const unsigned wq = s0[2 * d0 + (r >> 3)][(r & 7) >> 1]; const float o0 = (r & 1) ? bfhi(wq) : bflo(wq);
                    dv[d0] = o0 - lam * (o[d0][r] * rli[r]); ss += dv[d0] * dv[d0]; }
                ss += __builtin_bit_cast(float, __builtin_amdgcn_update_dpp(0, __builtin_bit_cast(int, ss), 0xB1, 0xF, 0xF, true));
                ss += __builtin_bit_cast(float, __builtin_amdgcn_update_dpp(0, __builtin_bit_cast(int, ss), 0x4E, 0xF, 0xF, true));
                ss += __builtin_bit_cast(float, __builtin_amdgcn_update_dpp(0, __builtin_bit_cast(int, ss), 0x141, 0xF, 0xF, true));
                ss += __builtin_bit_cast(float, __builtin_amdgcn_update_dpp(0, __builtin_bit_cast(int, ss), 0x140, 0xF, 0xF, true));
                { const auto sw = __builtin_amdgcn_permlane16_swap(__float_as_uint(ss), __float_as_uint(ss), false, false); ss = __uint_as_float(sw[0]) + __uint_as_float(sw[1]); }
                const float rn = __builtin_amdgcn_rsqf(ss * (1.0f / 128.0f) + EPS);
#pragma unroll
                for (int d0 = 0; d0 < 4; ++d0) stl[((r & 3) + 8 * (r >> 2)) * 128 + d0 * 32] = (unsigned short)f2bf(dv[d0] * rn * gsub[d0]); }
            LDS_WAIT();
            bf16* Ow = O + (size_t)b * (DBS / 2) + (size_t)(q0 + wid * 32 + (le >> 4)) * DM + h * 128 + (le & 15) * 8;
            const LAS unsigned short* sr = stg + (le >> 4) * 128 + (le & 15) * 8;
#pragma unroll
            for (int i = 0; i < 8; ++i) { const v4u v = *(const LAS v4u*)(sr + i * 4 * 128); *(v4u*)(Ow + (long)i * 4 * DM) = v; }
        }
        if (c == 1) { WAIT_BAR(8); } else { WAIT_BAR(0); }
    }
#undef ROT
}
#undef SBAR
#undef PIN
#undef MF
#undef WAIT_BAR
constexpr int NUNITS = BATCH * NH * 16;
__device__ __forceinline__ bool unit_of(int i, int G, int vcu, int& b, int& h, int& qb) {
    const int Lx = i * G + vcu; if (Lx >= NUNITS) return false;
    const int rnd = Lx >> 8, w = Lx & 3, bh = (Lx & 255) >> 2; qb = rnd == 0 ? w : rnd == 1 ? 7 - w : rnd == 2 ? 8 + w : 15 - w; b = bh >> 3; h = bh & 7; return true;
}
__device__ __forceinline__ void phase(Frame& F) {
    float lam;
    { const float a = F.in[5][F.lane] * F.in[6][F.lane], bq = F.in[7][F.lane] * F.in[8][F.lane]; lam = expf(wave_sum(a)) - expf(wave_sum(bq)) + LAMBDA_INIT; lam = __uint_as_float(__builtin_amdgcn_readfirstlane(__float_as_uint(lam))); }
    const bf16* Q = (const bf16*)(F.ws + WS_B0 + O_Q); const bf16* K = (const bf16*)(F.ws + WS_B0 + O_K); const bf16* V = (const bf16*)(F.ws + WS_B0 + O_V); bf16* O = (bf16*)F.out;
    LAS unsigned char* lds = F.lds + RING_OFF;
    int b, h, qb;
    if (!unit_of(0, F.G, F.vcu, b, h, qb)) return;
    bf16x8 qr[4]; int sl_prev = 0, sl_cur = 0, sl_next = SLOTV;
    {
        const int wid = F.wave, lane = F.lane; const unsigned lds0 = (unsigned)(uintptr_t)lds; const unsigned kdst = lds0 + L_K + wid * 1024, vdst = lds0 + L_V + wid * 1024;
        const PassSrc p0 = pass_src(b, h, qb, 0, Q, K, V, lane, wid);
        ATT_DMA_K(p0.ksrc, 0); ATT_DMA_V(p0.vsrc, 0, 0); ATT_DMA_K(p0.ksrc, 1); ATT_DMA_K(p0.ksrc, 2);
#pragma unroll
        for (int d0 = 0; d0 < 4; ++d0) qr[d0] = *reinterpret_cast<const bf16x8*>(p0.qw + d0 * 16);
        asm volatile("s_waitcnt vmcnt(0) lgkmcnt(0)\n\ts_barrier" ::: "memory");
    }
    bool first = true;
#pragma unroll 1
    for (int i = 0;; ++i) {
        int nb, nh, nqb; const bool more = unit_of(i + 1, F.G, F.vcu, nb, nh, nqb);
        { const PassSrc nx = pass_src(b, h, qb, 1, Q, K, V, F.lane, F.wave);
          apass(b, h, qb, 0, first, true, nx, K, V, O, lds, lam, F.in[23], F.in[9], qr, sl_prev, sl_cur, sl_next); first = false; }
        { PassSrc nx = pass_src(more ? nb : b, more ? nh : h, more ? nqb : qb, 0, Q, K, V, F.lane, F.wave);
          apass(b, h, qb, 1, false, more, nx, K, V, O, lds, lam, F.in[23], F.in[9], qr, sl_prev, sl_cur, sl_next); }
        if (!more) break;
        b = nb; h = nh; qb = nqb;
    }
}
}

#ifndef MK_N_LAUNCHES
#define MK_N_LAUNCHES 1
#endif
constexpr int N_LAUNCHES = MK_N_LAUNCHES, PER_PHASE = 8;
struct Args { const float* in[24]; float* out; unsigned char* ws; int ph_lo, ph_hi, li, pad; };
__global__ void __launch_bounds__(NWAVES * 64, 2) fwd_kernel(Args args) {
    extern __shared__ __attribute__((aligned(16))) unsigned char lds[];
    Frame F;
    F.lds = (LAS unsigned char*)lds;
    F.MISC = (volatile LAS unsigned*)(F.lds + MISC_OFF);
    F.tid = threadIdx.x; F.lane = F.tid & 63; F.wave = __builtin_amdgcn_readfirstlane(F.tid >> 6);
    F.G = gridDim.x; { const int bx = blockIdx.x; F.vcu = (F.G % 8 == 0) ? (bx % 8) * (F.G / 8) + bx / 8 : bx; }
#pragma unroll
    for (int i = 0; i < 24; ++i) F.in[i] = args.in[i];
    F.out = args.out; F.ws = args.ws;
    F.ctl = (gu32*)(args.ws + WS_CTL);
    for (int u = F.tid; u < (LDS_BYTES - LDSCTL_OFF) / 4; u += NWAVES * 64) ((LAS unsigned*)(F.lds + LDSCTL_OFF))[u] = 0u;
    __syncthreads();
    const bool grouped = (F.G == 256);
    XcdBarrier bar; bar.bar = (unsigned*)(F.ctl + CW_BAR); bar.x = 0; bar.st = nullptr; bar.members = 0; XcdBarrier gbar = bar, qbar = bar;
    if (N_LAUNCHES != PER_PHASE) {
        bar = xcd_barrier_post((unsigned*)(F.ctl + CW_BAR), F.MISC + 8, (unsigned)F.G);
        if (grouped) gbar = xcd_barrier_post((unsigned*)(F.ctl + CW_BAR) + (1 + ((int)blockIdx.x & 7)) * XCD_BAR_WORDS, F.MISC + 10, (unsigned)F.G / 8u);
        if (grouped) qbar = xcd_barrier_post((unsigned*)(F.ctl + CW_QBAR) + (((int)blockIdx.x & 7) * 8 + (((int)blockIdx.x >> 3) & 7)) * XCD_BAR_WORDS, F.MISC + 12, 4u);
    }
#define GRID_BAR() do { if (N_LAUNCHES != PER_PHASE) xcd_barrier(bar); } while (0)
#define GROUP_BAR() do { if (N_LAUNCHES != PER_PHASE) { if (grouped) xcd_barrier(gbar); else xcd_barrier(bar); } } while (0)
#define QUAD_BAR() do { if (N_LAUNCHES != PER_PHASE) { if (grouped) xcd_barrier(qbar); else xcd_barrier(bar); } } while (0)
    const int lo = args.ph_lo, hi = args.ph_hi;
#define IN(k) (lo <= (k) && (k) < hi)
#define BOTH(k) (IN(k) && IN((k) + 1))
    unsigned char* ws = args.ws;
    const bf16* XN = (const bf16*)F.out; const bf16* AO = (const bf16*)F.out; const bf16* R = (const bf16*)((const unsigned char*)F.out + DO_R);
    unsigned char* wb = ws + WS_B0;

    if (IN(0)) { p0_prologue(F); if (BOTH(0)) GRID_BAR(); }

    if (IN(1)) {
        pg8::Gemm g{XN, (const bf16*)(ws + WS_WIN), nullptr, nullptr, DBS, 0, M, NIN, DM}; pg8::StaticOrder S; S.init(M, NIN, F.G, (int)blockIdx.x); S.rot = true;
        pg8::EpiIn E{(bf16*)(wb + O_Q), BST / 2, SEC / 2, F.in[3], F.in[4]};
        pg8::gemm_phase<pg8::EpiIn, pg8::StaticOrder, PG8_ALIGN, PG8_SP2>(F.lds + RING_OFF, g, S, E);
        if (IN(3)) GROUP_BAR();
    }
    if (IN(3)) { lru::phase(F); att::phase(F); if (IN(4)) GROUP_BAR(); }
    if (IN(4)) {
        pg8::Gemm g{AO, (const bf16*)(ws + WS_WPA), R, (const bf16*)(ws + WS_WPR), DBS, DBS, M, DM, DM}; pg8::PairOrder S; S.init(M, DM, F.G, (int)blockIdx.x);
        pg8::EpiMerge E{(const bf16*)(wb + O_SGA), (const bf16*)(wb + O_SGR), (bf16*)(wb + O_MERGED), BST / 2};
        pg8::gemm_phase<pg8::EpiMerge, pg8::PairOrder, PG8_ALIGN, PG8_SP2>(F.lds + RING_OFF, g, S, E);
        if (BOTH(4)) GROUP_BAR();
    }
    if (IN(5)) {
        pg8::Gemm g{(const bf16*)(wb + O_MERGED), (const bf16*)(ws + WS_WOUT), nullptr, nullptr, BST, 0, M, DM, DM}; pg8::StaticOrder S; S.init(M, DM, F.G, (int)blockIdx.x);
        pg8::EpiX1 E{F.in[0], (bf16*)(wb + O_XN2), (float*)(ws + WS_ROWSQ), BST / 2};
        pg8::gemm_phase<pg8::EpiX1, pg8::StaticOrder, PG8_ALIGN, PG8_SP2>(F.lds + RING_OFF, g, S, E);
        if (BOTH(5)) QUAD_BAR();
    }
    if (IN(6)) {
        pg8::Gemm g{(const bf16*)(wb + O_XN2), (const bf16*)(ws + WS_WUP), nullptr, nullptr, BST, 0, M, FF, DM}; pg8::StaticOrder S; S.init(M, FF, F.G, (int)blockIdx.x);
        pg8::EpiUp E{(const float*)(ws + WS_ROWSQ), (bf16*)(wb + O_UP), BST / 2, {{0.f, 0.f, 0.f, 0.f}, {0.f, 0.f, 0.f, 0.f}}, -1};
        pg8::gemm_phase<pg8::EpiUp, pg8::StaticOrder, PG8_ALIGN, PG8_SP2>(F.lds + RING_OFF, g, S, E);
        if (BOTH(6)) QUAD_BAR();
    }
    if (IN(7)) {
        pg8::Gemm g{(const bf16*)(wb + O_UP), (const bf16*)(ws + WS_WDN), nullptr, nullptr, BST, 0, M, DM, FF}; pg8::StaticOrder S; S.init(M, DM, F.G, (int)blockIdx.x);
        pg8::EpiDown E{(const bf16*)(wb + O_XN2), F.out, BST / 2};
        pg8::gemm_phase<pg8::EpiDown, pg8::StaticOrder, PG8_ALIGN, PG8_SP2>(F.lds + RING_OFF, g, S, E);
    }
#undef GROUP_BAR
#undef QUAD_BAR
#undef IN
#undef BOTH
#undef GRID_BAR
}

extern "C" void kernel_launch(void* const* d_in, const int* in_sizes, int n_in, void* d_out, int out_size, void* d_ws, size_t ws_size, hipStream_t stream) {
    static int grid = 0;
    if (grid == 0) {
        if (n_in != 24 || in_sizes[0] != M * DM || out_size != M * DM || ws_size < WS_END) {
            fprintf(stderr, "kernel_launch: unexpected shapes: n_in %d in0 %d out %d ws %zu (need %zu)\n", n_in, n_in > 0 ? in_sizes[0] : -1, out_size, ws_size, (size_t)WS_END); grid = -1; return; }
        int dev = 0, cus = 0, per_cu = 0;
        if (hipGetDevice(&dev) != hipSuccess || hipDeviceGetAttribute(&cus, hipDeviceAttributeMultiprocessorCount, dev) != hipSuccess) { grid = -1; return; }
        if (hipFuncSetAttribute((const void*)fwd_kernel, hipFuncAttributeMaxDynamicSharedMemorySize, LDS_BYTES) != hipSuccess) { fprintf(stderr, "kernel_launch: hipFuncSetAttribute failed\n"); grid = -1; return; }
        if (hipOccupancyMaxActiveBlocksPerMultiprocessor(&per_cu, (const void*)fwd_kernel, NWAVES * 64, LDS_BYTES) != hipSuccess || per_cu < 1) {
            fprintf(stderr, "kernel_launch: occupancy query reports %d workgroups per CU\n", per_cu); per_cu = 1; }
        (void)hipGetLastError();
        grid = cus;
    }
    if (grid < 0) return;
    if (hipMemsetAsync((char*)d_ws + WS_CTL, 0, CTL_ZERO_BYTES, stream) != hipSuccess) { fprintf(stderr, "kernel_launch: memset failed\n"); return; }
    Args a{};
    for (int i = 0; i < 24; ++i) a.in[i] = (const float*)d_in[i];
    a.out = (float*)d_out; a.ws = (unsigned char*)d_ws;
    for (int li = 0; li < N_LAUNCHES; ++li) {
        a.ph_lo = (N_LAUNCHES == PER_PHASE) ? li : 0; a.ph_hi = (N_LAUNCHES == PER_PHASE) ? li + 1 : PER_PHASE; a.li = li;
        hipLaunchKernelGGL(fwd_kernel, dim3(grid), dim3(NWAVES * 64), LDS_BYTES, stream, a);
        const hipError_t le = hipPeekAtLastError();
        if (le != hipSuccess) { fprintf(stderr, "kernel_launch: launch %d failed: %s\n", li, hipGetErrorName(le)); break; }
    }
}
```

```cpp
#include <hip/hip_runtime.h>
#include <cstdio>
#include <cstdint>

constexpr int BATCH = 8, SEQ = 4096, DM = 1024, M = BATCH * SEQ, NH = 8, FF = 4096, NIN = 7168;
constexpr float EPS = 1e-6f;
constexpr float LOG2E = 1.4426950408889634f;
constexpr float C2 = 0.125f * LOG2E;
constexpr float LAMBDA_INIT = 0.2f;

namespace pg8 {
#define PG8_LAS __attribute__((address_space(3)))
typedef unsigned short bf16_t;
typedef short bf16x8 __attribute__((ext_vector_type(8)));
typedef float f32x4 __attribute__((ext_vector_type(4)));
typedef unsigned u32x4 __attribute__((ext_vector_type(4)));
typedef unsigned u32x2 __attribute__((ext_vector_type(2)));
constexpr int BM = 256, BK = 64, HALF = 128, HTB = HALF * BK * 2, STAGE_BYTES = 8 * HTB, NXCD = 8, WGM = 8;

__host__ __device__ __forceinline__ int lds_byte(int r, int c) { const int st = (r >> 4) * 2 + (c >> 5), rr = r & 15, cc = c & 31, ob = rr * 64 + cc * 2; return st * 1024 + (ob ^ (((ob >> 9) & 1) << 5)); }
__host__ __device__ __forceinline__ void stage_rc(int b, int& R, int& C) { const int st = b / 1024, sb = b % 1024, swz = sb ^ (((sb >> 9) & 1) << 5); R = (st >> 1) * 16 + swz / 64; C = (st & 1) * 32 + (swz % 64) / 2; }
__host__ __device__ __forceinline__ int perm32(int rho) { const int n = rho >> 4, i = rho & 15; return 8 * (i >> 2) + 4 * n + (i & 3); }

struct Unit { int pm, pn, z; };
struct Gemm { const bf16_t* A; const bf16_t* Bt; const bf16_t* A2; const bf16_t* Bt2; size_t abs, abs2; int M, N, K; };

struct StaticOrder {
    int nM, nN, nwg, G, c; bool rot = false;
    __host__ __device__ void init(int M_, int N_, int G_, int c_) { nM = M_ / BM; nN = N_ / BM; nwg = nM * nN; G = G_; c = c_; }
    __host__ __device__ bool next(int i, Unit& u) const {
        const long L = (long)i * G + c; if (L >= nwg) return false;
        int wgid = (int)L; { const int q = nwg / NXCD, r = nwg % NXCD, xcd = wgid % NXCD, off = wgid / NXCD; wgid = (xcd < r ? xcd * (q + 1) : r * (q + 1) + (xcd - r) * q) + off; }
        const int nig = WGM * nN, gid = wgid / nig, fm = gid * WGM, gsz = (nM - fm) < WGM ? (nM - fm) : WGM;
        u.pm = fm + ((wgid % nig) % gsz); u.pn = (wgid % nig) / gsz; u.z = 0;
        if (rot) { const int slot = u.pn & 3, t = u.pn >> 2; u.pn = ((t + slot) % (nN >> 2)) * 4 + slot; }
        return true;
    }
};
struct PairOrder {
    StaticOrder base;
    __host__ __device__ void init(int M_, int N_, int G_, int c_) { base.init(M_, N_, G_, c_); }
    __host__ __device__ bool next(int i, Unit& u) const { if (!base.next(i >> 1, u)) return false; u.z = i & 1; return true; }
};

__device__ __forceinline__ unsigned cvt_pk_bf16(float lo, float hi) { unsigned r; asm volatile("v_cvt_pk_bf16_f32 %0, %1, %2" : "=v"(r) : "v"(lo), "v"(hi)); return r; }
__device__ __forceinline__ float bf_lo(unsigned w) { return __uint_as_float(w << 16); }
__device__ __forceinline__ float bf_hi(unsigned w) { return __uint_as_float(w & 0xffff0000u); }
__device__ __forceinline__ float sigmoid_f(float x) { return __builtin_amdgcn_rcpf(1.0f + __builtin_amdgcn_exp2f(-LOG2E * x)); }
__device__ __forceinline__ float gelu_tanh_f(float x) { const float u = x * (1.0f + 0.044715f * x * x); return x * sigmoid_f(1.5957691216057308f * u); }


struct EpiIn {
    static constexpr bool PERM = true, KEEP = false;
    bf16_t* out0; size_t bse, sect_stride; const float* qg; const float* kg;
    __device__ __forceinline__ void operator()(f32x4 (&acc)[2][2][4][2], const Unit& u, int wr, int wc, int fr, int fq) const {
        const int type = u.pn >> 2, colt = (u.pn & 3) * BM;
        bf16_t* base = out0 + (size_t)(u.pm >> 4) * bse + (size_t)type * sect_stride;
        const int row0 = (u.pm & 15) * BM + wr * 64 + fr;
        if (type <= 1) {
            const float* g = type == 0 ? qg : kg; const float sc = type == 0 ? C2 : 1.0f;
            f32x4 gv[2][2];
#pragma unroll
            for (int bj = 0; bj < 2; ++bj)
#pragma unroll
                for (int n = 0; n < 2; ++n) gv[bj][n] = *(const f32x4*)(g + 32 * bj + 8 * fq + 4 * n) * sc;
            const int col0 = colt + 64 * wc + 8 * fq;
#pragma unroll
            for (int ai = 0; ai < 2; ++ai)
#pragma unroll
                for (int m = 0; m < 4; ++m) { bf16_t* rowp = base + (size_t)(row0 + ai * HALF + m * 16) * DM + col0;
                    float ss = 0.f;
#pragma unroll
                    for (int bj = 0; bj < 2; ++bj)
#pragma unroll
                        for (int n = 0; n < 2; ++n) { const f32x4 x = acc[ai][bj][m][n]; ss += (x[0] * x[0] + x[1] * x[1]) + (x[2] * x[2] + x[3] * x[3]); }
                    ss += __shfl_xor(ss, 16); ss += __shfl_xor(ss, 32);
                    const float rinv = __builtin_amdgcn_rsqf(ss * (1.0f / 64.0f) + EPS);
#pragma unroll
                    for (int bj = 0; bj < 2; ++bj) { const f32x4 v0 = acc[ai][bj][m][0] * rinv * gv[bj][0], v1 = acc[ai][bj][m][1] * rinv * gv[bj][1];
                        u32x4 w; w.x = cvt_pk_bf16(v0[0], v0[1]); w.y = cvt_pk_bf16(v0[2], v0[3]); w.z = cvt_pk_bf16(v1[0], v1[1]); w.w = cvt_pk_bf16(v1[2], v1[3]);
                        __builtin_nontemporal_store(w, (u32x4*)(rowp + 32 * bj)); } }
        } else {
            const int col0 = colt + wc * 32 + 8 * fq;
#pragma unroll
            for (int ai = 0; ai < 2; ++ai)
#pragma unroll
                for (int m = 0; m < 4; ++m) { bf16_t* rowp = base + (size_t)(row0 + ai * HALF + m * 16) * DM + col0;
#pragma unroll
                    for (int bj = 0; bj < 2; ++bj) { f32x4 v0 = acc[ai][bj][m][0], v1 = acc[ai][bj][m][1];
                        if (type == 4) {
#pragma unroll
                            for (int i = 0; i < 4; ++i) { v0[i] = gelu_tanh_f(v0[i]); v1[i] = gelu_tanh_f(v1[i]); }
                        } else if (type == 5) {
#pragma unroll
                            for (int i = 0; i < 4; ++i) { v0[i] = 1.0f + __builtin_amdgcn_exp2f(-LOG2E * v0[i]); v1[i] = 1.0f + __builtin_amdgcn_exp2f(-LOG2E * v1[i]); }
                        } else if (type == 6) {
#pragma unroll
                            for (int i = 0; i < 4; ++i) { v0[i] = sigmoid_f(v0[i]); v1[i] = sigmoid_f(v1[i]); }
                        }
                        u32x4 w; w.x = cvt_pk_bf16(v0[0], v0[1]); w.y = cvt_pk_bf16(v0[2], v0[3]); w.z = cvt_pk_bf16(v1[0], v1[1]); w.w = cvt_pk_bf16(v1[2], v1[3]);
                        __builtin_nontemporal_store(w, (u32x4*)(rowp + bj * HALF)); } }
        }
    }
};

struct EpiMerge {
    static constexpr bool PERM = true, KEEP = true;
    const bf16_t* __restrict__ sga; const bf16_t* __restrict__ sgr; bf16_t* __restrict__ out; size_t bse;
    __device__ __forceinline__ void operator()(f32x4 (&acc)[2][2][4][2], const Unit& u, int wr, int wc, int fr, int fq) const {
        const int row0 = (u.pm & 15) * BM + wr * 64 + fr, col0 = u.pn * BM + wc * 32 + 8 * fq; const size_t boff = (size_t)(u.pm >> 4) * bse;
#pragma unroll
        for (int ai = 0; ai < 2; ++ai) {
            u32x4 gr[4][2], ga[4][2];
#pragma unroll
            for (int m = 0; m < 4; ++m)
#pragma unroll
                for (int bj = 0; bj < 2; ++bj) { const size_t off = boff + (size_t)(row0 + ai * HALF + m * 16) * DM + col0 + bj * HALF;
                    gr[m][bj] = *(const u32x4*)(sgr + off); if (u.z == 0) ga[m][bj] = *(const u32x4*)(sga + off); }
#pragma unroll
            for (int m = 0; m < 4; ++m)
#pragma unroll
                for (int bj = 0; bj < 2; ++bj) { const size_t off = boff + (size_t)(row0 + ai * HALF + m * 16) * DM + col0 + bj * HALF;
                    const u32x4 g = gr[m][bj];
                    const f32x4 r0 = (f32x4){bf_lo(g.x), bf_hi(g.x), bf_lo(g.y), bf_hi(g.y)}, r1 = (f32x4){bf_lo(g.z), bf_hi(g.z), bf_lo(g.w), bf_hi(g.w)};
                    if (u.z == 0) {
                        const u32x4 h = ga[m][bj];
                        const f32x4 a0 = (f32x4){bf_lo(h.x), bf_hi(h.x), bf_lo(h.y), bf_hi(h.y)}, a1 = (f32x4){bf_lo(h.z), bf_hi(h.z), bf_lo(h.w), bf_hi(h.w)};
#pragma unroll
                        for (int i = 0; i < 4; ++i) { acc[ai][bj][m][0][i] *= __builtin_amdgcn_rcpf(a0[i] * r0[i]); acc[ai][bj][m][1][i] *= __builtin_amdgcn_rcpf(a1[i] * r1[i]); }
                    } else {
                        const f32x4 v0 = acc[ai][bj][m][0] * r0, v1 = acc[ai][bj][m][1] * r1;
                        u32x4 w; w.x = cvt_pk_bf16(v0[0], v0[1]); w.y = cvt_pk_bf16(v0[2], v0[3]); w.z = cvt_pk_bf16(v1[0], v1[1]); w.w = cvt_pk_bf16(v1[2], v1[3]);
                        *(u32x4*)(out + off) = w;
                    } } }
    }
};

struct EpiX1 {
    static constexpr bool PERM = true, KEEP = false;
    const float* __restrict__ x; bf16_t* __restrict__ xn2; float* __restrict__ rowsq; size_t bse;
    __device__ __forceinline__ void operator()(f32x4 (&acc)[2][2][4][2], const Unit& u, int wr, int wc, int fr, int fq) const {
        const int row0 = u.pm * BM + wr * 64 + fr, col0 = u.pn * BM + wc * 32 + 8 * fq;
#pragma unroll
        for (int ai = 0; ai < 2; ++ai) {
            f32x4 xv[4][2][2];
#pragma unroll
            for (int m = 0; m < 4; ++m)
#pragma unroll
                for (int bj = 0; bj < 2; ++bj)
#pragma unroll
                    for (int n = 0; n < 2; ++n) xv[m][bj][n] = *(const f32x4*)(x + (size_t)(row0 + ai * HALF + m * 16) * DM + col0 + bj * HALF + n * 4);
#pragma unroll
            for (int m = 0; m < 4; ++m) { const int row = row0 + ai * HALF + m * 16; float ss = 0.f;
                bf16_t* rowp = xn2 + (size_t)(u.pm >> 4) * bse + (size_t)(row & 4095) * DM + col0;
#pragma unroll
                for (int bj = 0; bj < 2; ++bj) { const f32x4 o0 = xv[m][bj][0] + acc[ai][bj][m][0], o1 = xv[m][bj][1] + acc[ai][bj][m][1];
                    ss += ((o0[0] * o0[0] + o0[1] * o0[1]) + (o0[2] * o0[2] + o0[3] * o0[3])) + ((o1[0] * o1[0] + o1[1] * o1[1]) + (o1[2] * o1[2] + o1[3] * o1[3]));
                    u32x4 w; w.x = cvt_pk_bf16(o0[0], o0[1]); w.y = cvt_pk_bf16(o0[2], o0[3]); w.z = cvt_pk_bf16(o1[0], o1[1]); w.w = cvt_pk_bf16(o1[2], o1[3]);
                    *(u32x4*)(rowp + bj * HALF) = w; }
                ss += __shfl_xor(ss, 16); ss += __shfl_xor(ss, 32);
                if (fq == 0) atomicAdd(rowsq + row, ss); } }
    }
};

struct EpiUp {
    static constexpr bool PERM = true, KEEP = false;
    const float* __restrict__ rowsq; bf16_t* __restrict__ out; size_t bse;
    mutable float rinv_c[2][4]; mutable int pm_c;
    __device__ __forceinline__ void operator()(f32x4 (&acc)[2][2][4][2], const Unit& u, int wr, int wc, int fr, int fq) const {
        const int row0 = u.pm * BM + wr * 64 + fr, col0 = u.pn * BM + wc * 32 + 8 * fq;
        if (u.pm != pm_c) {
            float rs[2][4];
#pragma unroll
            for (int ai = 0; ai < 2; ++ai)
#pragma unroll
                for (int m = 0; m < 4; ++m) rs[ai][m] = rowsq[row0 + ai * HALF + m * 16];
#pragma unroll
            for (int ai = 0; ai < 2; ++ai)
#pragma unroll
                for (int m = 0; m < 4; ++m) rinv_c[ai][m] = __builtin_amdgcn_rsqf(rs[ai][m] * (1.0f / DM) + EPS);
            pm_c = u.pm; }
#pragma unroll
        for (int ai = 0; ai < 2; ++ai)
#pragma unroll
            for (int m = 0; m < 4; ++m) { const int row = row0 + ai * HALF + m * 16; const float rinv = rinv_c[ai][m];
                bf16_t* rowp = out + (size_t)(u.pm >> 4) * bse + (size_t)(row & 4095) * FF + col0;
#pragma unroll
                for (int bj = 0; bj < 2; ++bj) { f32x4 v0 = acc[ai][bj][m][0] * rinv, v1 = acc[ai][bj][m][1] * rinv;
#pragma unroll
                    for (int i = 0; i < 4; ++i) { const float a = fmaxf(v0[i], 0.f), b = fmaxf(v1[i], 0.f); v0[i] = a * a; v1[i] = b * b; }
                    u32x4 w; w.x = cvt_pk_bf16(v0[0], v0[1]); w.y = cvt_pk_bf16(v0[2], v0[3]); w.z = cvt_pk_bf16(v1[0], v1[1]); w.w = cvt_pk_bf16(v1[2], v1[3]);
                    *(u32x4*)(rowp + bj * HALF) = w; } }
    }
};

struct EpiDown {
    static constexpr bool PERM = true, KEEP = false;
    const bf16_t* __restrict__ xn2; float* __restrict__ dst; size_t bse;
    __device__ __forceinline__ void operator()(f32x4 (&acc)[2][2][4][2], const Unit& u, int wr, int wc, int fr, int fq) const {
        const int row0 = u.pm * BM + wr * 64 + fr, col0 = u.pn * BM + wc * 32 + 8 * fq;
        u32x4 rv[2][4][2];
#pragma unroll
        for (int ai = 0; ai < 2; ++ai)
#pragma unroll
            for (int m = 0; m < 4; ++m)
#pragma unroll
                for (int bj = 0; bj < 2; ++bj) rv[ai][m][bj] = *(const u32x4*)(xn2 + (size_t)(u.pm >> 4) * bse + (size_t)((row0 + ai * HALF + m * 16) & 4095) * DM + col0 + bj * HALF);
#pragma unroll
        for (int ai = 0; ai < 2; ++ai)
#pragma unroll
            for (int m = 0; m < 4; ++m)
#pragma unroll
                for (int bj = 0; bj < 2; ++bj) { const u32x4 g = rv[ai][m][bj]; float* rowp = dst + (size_t)(row0 + ai * HALF + m * 16) * DM + col0 + bj * HALF;
                    const f32x4 r0 = (f32x4){bf_lo(g.x), bf_hi(g.x), bf_lo(g.y), bf_hi(g.y)}, r1 = (f32x4){bf_lo(g.z), bf_hi(g.z), bf_lo(g.w), bf_hi(g.w)};
                    *(f32x4*)(rowp) = r0 + acc[ai][bj][m][0]; *(f32x4*)(rowp + 4) = r1 + acc[ai][bj][m][1]; }
    }
};

template <class Epi, class Sched, bool ALIGN_EPI = false, bool SP2 = false>
__device__ __forceinline__ void gemm_phase(PG8_LAS unsigned char* lds, const Gemm g, const Sched& S, const Epi& E) {
    const int tid = threadIdx.x, wid = __builtin_amdgcn_readfirstlane(tid >> 6), lane = tid & 63, wr = wid >> 2, wc = wid & 3, fr = lane & 15, fq = lane >> 4;
    const int K = g.K, nt = K / BK;
    unsigned voffA[2], voffB[2];
#pragma unroll
    for (int i = 0; i < 2; ++i) { int R, C; stage_rc(tid * 16 + i * 8192, R, C); const int Rb = Epi::PERM ? ((R & ~31) + perm32(R & 31)) : R;
        voffA[i] = (unsigned)(R * K + C) * 2u; voffB[i] = (unsigned)(Rb * K + C) * 2u; }
    const size_t kstep = (size_t)(BK * 2);
    const size_t hstep = (size_t)HALF * K * 2;
    const size_t tstep = 2 * hstep;
    const unsigned ldsw = (unsigned)wid * 1024u;
    const int aoff = lds_byte(wr * 64 + fr, fq * 8), boff = lds_byte(wc * 32 + fr, fq * 8);
#define PG8_SA(b, h) (((b) * 2 + (h)) * HTB)
#define PG8_SB(b, h) ((4 + (b) * 2 + (h)) * HTB)
#define PG8_STAGE(bufoff, gbase, voff) do { _Pragma("unroll") for (int _i = 0; _i < 2; ++_i) \
        __builtin_amdgcn_global_load_lds((const unsigned*)((const char*)(gbase) + (voff)[_i]), (PG8_LAS unsigned*)(lds + (bufoff) + ldsw + _i * 8192), 16, 0, 0); } while (0)
#define PG8_LDA(dst, b, h) do { _Pragma("unroll") for (int m = 0; m < 4; ++m) _Pragma("unroll") for (int k = 0; k < 2; ++k) dst[m][k] = *(const PG8_LAS bf16x8*)(lds + PG8_SA(b, h) + aoff + m * 2048 + k * 1024); } while (0)
#define PG8_LDB(dst, b, h) do { _Pragma("unroll") for (int n = 0; n < 2; ++n) _Pragma("unroll") for (int k = 0; k < 2; ++k) dst[n][k] = *(const PG8_LAS bf16x8*)(lds + PG8_SB(b, h) + boff + n * 2048 + k * 1024); } while (0)
#define PG8_MMA(ai, bj, At, Bt) do { __builtin_amdgcn_s_setprio(1); _Pragma("unroll") for (int m = 0; m < 4; ++m) _Pragma("unroll") for (int n = 0; n < 2; ++n) _Pragma("unroll") for (int k = 0; k < 2; ++k) \
        acc[ai][bj][m][n] = __builtin_amdgcn_mfma_f32_16x16x32_bf16(Bt[n][k], At[m][k], acc[ai][bj][m][n], 0, 0, 0); __builtin_amdgcn_s_setprio(0); } while (0)
#define PG8_WAIT_V(n) asm volatile("s_waitcnt vmcnt(" #n ")" ::: "memory")
#define PG8_WAIT_L(n) asm volatile("s_waitcnt lgkmcnt(" #n ")" ::: "memory")
#define PG8_BAR __builtin_amdgcn_s_barrier()
#define PG8_SCHED __builtin_amdgcn_sched_barrier(0)
    Unit cur, nxt; int ui = 0;
    if (!S.next(0, cur)) return;
    f32x4 acc[2][2][4][2];
#pragma unroll
    for (int a = 0; a < 2; ++a)
#pragma unroll
        for (int b = 0; b < 2; ++b)
#pragma unroll
            for (int m = 0; m < 4; ++m)
#pragma unroll
                for (int n = 0; n < 2; ++n) acc[a][b][m][n] = (f32x4){0.f, 0.f, 0.f, 0.f};
    bf16x8 At[4][2], B0[2][2], B1[2][2];
#define PG8_ABASE(u) ((const char*)((u).z ? g.A2 : g.A) + (size_t)((u).pm >> 4) * ((u).z ? g.abs2 : g.abs) + (size_t)((u).pm & 15) * tstep)
    const char* cA = PG8_ABASE(cur); const char* cB = (const char*)(cur.z ? g.Bt2 : g.Bt) + (size_t)cur.pn * tstep;
    if constexpr (SP2) {
        PG8_STAGE(PG8_SB(0, 0), cB, voffB); PG8_STAGE(PG8_SB(0, 1), cB + hstep, voffB); PG8_STAGE(PG8_SA(0, 0), cA, voffA); PG8_STAGE(PG8_SA(0, 1), cA + hstep, voffA);
        if (wr == 1) PG8_BAR;
        PG8_WAIT_V(2); PG8_BAR;
        PG8_STAGE(PG8_SB(1, 0), cB + kstep, voffB); PG8_STAGE(PG8_SA(1, 0), cA + kstep, voffA); PG8_STAGE(PG8_SB(1, 1), cB + hstep + kstep, voffB);
        PG8_WAIT_V(6); PG8_BAR;
    } else {
        PG8_STAGE(PG8_SB(0, 0), cB, voffB); PG8_STAGE(PG8_SA(0, 0), cA, voffA); PG8_STAGE(PG8_SB(0, 1), cB + hstep, voffB); PG8_STAGE(PG8_SA(0, 1), cA + hstep, voffA);
        if (wr == 1) PG8_BAR;
        PG8_WAIT_V(4); PG8_BAR;
        PG8_STAGE(PG8_SB(1, 0), cB + kstep, voffB); PG8_STAGE(PG8_SA(1, 0), cA + kstep, voffA); PG8_STAGE(PG8_SB(1, 1), cB + hstep + kstep, voffB);
        PG8_WAIT_V(6); PG8_BAR;
    }
    for (;;) {
        const bool has_next = S.next(ui + 1, nxt);
        const char* nA = has_next ? PG8_ABASE(nxt) : cA; const char* nB = has_next ? (const char*)(nxt.z ? g.Bt2 : g.Bt) + (size_t)nxt.pn * tstep : cB;
        for (int t = 0; t < nt; t += 2) {
            const bool last = (t == nt - 2);
            const char* a1 = cA + (size_t)(t + 1) * kstep;
            const char* a2 = last ? nA : cA + (size_t)(t + 2) * kstep; const char* b2 = last ? nB : cB + (size_t)(t + 2) * kstep;
            const char* a3 = a2 + kstep; const char* b3 = b2 + kstep;
            if constexpr (SP2) {
            PG8_LDB(B0, 0, 0); PG8_LDB(B1, 0, 1); PG8_SCHED; PG8_LDA(At, 0, 0); PG8_STAGE(PG8_SA(1, 1), a1 + hstep, voffA);
            PG8_WAIT_V(8); PG8_WAIT_L(0); PG8_BAR; PG8_MMA(0, 0, At, B0); PG8_MMA(0, 1, At, B1); PG8_BAR; PG8_SCHED;
            PG8_LDA(At, 0, 1); PG8_STAGE(PG8_SB(0, 0), b2, voffB); PG8_STAGE(PG8_SB(0, 1), b2 + hstep, voffB); PG8_STAGE(PG8_SA(0, 0), a2, voffA);
            PG8_WAIT_V(8); PG8_WAIT_L(0); PG8_BAR; PG8_MMA(1, 0, At, B0); PG8_MMA(1, 1, At, B1); PG8_BAR; PG8_SCHED;
            PG8_LDB(B0, 1, 0); PG8_LDB(B1, 1, 1); PG8_SCHED; PG8_LDA(At, 1, 0); PG8_STAGE(PG8_SA(0, 1), a2 + hstep, voffA);
            PG8_WAIT_V(8); PG8_WAIT_L(0); PG8_BAR; PG8_MMA(0, 0, At, B0); PG8_MMA(0, 1, At, B1); PG8_BAR; PG8_SCHED;
            PG8_LDA(At, 1, 1); PG8_STAGE(PG8_SB(1, 0), b3, voffB); PG8_STAGE(PG8_SB(1, 1), b3 + hstep, voffB); PG8_STAGE(PG8_SA(1, 0), a3, voffA);
            PG8_WAIT_V(8); PG8_WAIT_L(0); PG8_BAR; PG8_MMA(1, 0, At, B0); PG8_MMA(1, 1, At, B1); PG8_BAR; PG8_SCHED;
            } else {
            PG8_LDB(B0, 0, 0); PG8_SCHED; PG8_LDA(At, 0, 0); PG8_STAGE(PG8_SA(1, 1), a1 + hstep, voffA);
            PG8_WAIT_L(8); PG8_BAR; PG8_WAIT_L(0); PG8_MMA(0, 0, At, B0); PG8_BAR; PG8_SCHED;
            PG8_LDB(B1, 0, 1); PG8_STAGE(PG8_SB(0, 0), b2, voffB);
            PG8_BAR; PG8_WAIT_L(0); PG8_MMA(0, 1, At, B1); PG8_BAR;
            PG8_LDA(At, 0, 1); PG8_STAGE(PG8_SA(0, 0), a2, voffA);
            PG8_BAR; PG8_WAIT_L(0); PG8_MMA(1, 0, At, B0); PG8_BAR; PG8_SCHED;
            PG8_STAGE(PG8_SB(0, 1), b2 + hstep, voffB);
            PG8_WAIT_V(6); PG8_BAR; PG8_MMA(1, 1, At, B1); PG8_BAR;
            PG8_LDB(B0, 1, 0); PG8_SCHED; PG8_LDA(At, 1, 0); PG8_STAGE(PG8_SA(0, 1), a2 + hstep, voffA);
            PG8_WAIT_L(8); PG8_BAR; PG8_WAIT_L(0); PG8_MMA(0, 0, At, B0); PG8_BAR; PG8_SCHED;
            PG8_LDB(B1, 1, 1); PG8_STAGE(PG8_SB(1, 0), b3, voffB);
            PG8_BAR; PG8_WAIT_L(0); PG8_MMA(0, 1, At, B1); PG8_BAR;
            PG8_LDA(At, 1, 1); PG8_STAGE(PG8_SA(1, 0), a3, voffA);
            PG8_BAR; PG8_WAIT_L(0); PG8_MMA(1, 0, At, B0); PG8_BAR; PG8_SCHED;
            PG8_STAGE(PG8_SB(1, 1), b3 + hstep, voffB);
            PG8_WAIT_V(6); PG8_BAR; PG8_MMA(1, 1, At, B1); PG8_BAR;
            }
        }
        if constexpr (ALIGN_EPI) { if (wr == 0) PG8_BAR; }
        E(acc, cur, wr, wc, fr, fq);
        if (!has_next) break;
        if (!(Epi::KEEP && cur.z == 0)) {
#pragma unroll
        for (int a = 0; a < 2; ++a)
#pragma unroll
            for (int b = 0; b < 2; ++b)
#pragma unroll
                for (int m = 0; m < 4; ++m)
#pragma unroll
                    for (int n = 0; n < 2; ++n) acc[a][b][m][n] = (f32x4){0.f, 0.f, 0.f, 0.f};
        }
        cur = nxt; cA = nA; cB = nB; ++ui;
        if constexpr (ALIGN_EPI) { if (wr == 1) PG8_BAR; }
    }
    PG8_WAIT_V(0);
    if constexpr (!ALIGN_EPI) { if (wr == 0) PG8_BAR; }
    PG8_BAR;
#undef PG8_ABASE
#undef PG8_SA
#undef PG8_SB
#undef PG8_STAGE
#undef PG8_LDA
#undef PG8_LDB
#undef PG8_MMA
#undef PG8_WAIT_V
#undef PG8_WAIT_L
#undef PG8_BAR
#undef PG8_SCHED
}
}

#ifndef PG8_SP2
#define PG8_SP2 true
#endif
#ifndef PG8_ALIGN
#define PG8_ALIGN true
#endif

#define GAS __attribute__((address_space(1)))
#define LAS __attribute__((address_space(3)))
typedef unsigned short bf16;
typedef unsigned v4u __attribute__((ext_vector_type(4)));
typedef unsigned v2u __attribute__((ext_vector_type(2)));
typedef float f32x4 __attribute__((ext_vector_type(4)));
typedef float f32x16 __attribute__((ext_vector_type(16)));
typedef short bf16x8 __attribute__((ext_vector_type(8)));
typedef short s16x4 __attribute__((ext_vector_type(4)));
typedef GAS unsigned gu32;
#define RLX_AGENT __ATOMIC_RELAXED, __HIP_MEMORY_SCOPE_AGENT
#define LDS_WAIT() asm volatile("s_waitcnt lgkmcnt(0)" ::: "memory")
#define VM_WAIT() asm volatile("s_waitcnt vmcnt(0)" ::: "memory")
typedef float f32x2_c __attribute__((ext_vector_type(2))); typedef __bf16 bf16x2_c __attribute__((ext_vector_type(2)));
__device__ __forceinline__ unsigned pk2(float lo, float hi) { f32x2_c v = {lo, hi}; bf16x2_c b = __builtin_convertvector(v, bf16x2_c); return __builtin_bit_cast(unsigned, b); }
__device__ __forceinline__ unsigned f2bf(float f) { return pk2(f, 0.f) & 0xffffu; }
__device__ __forceinline__ float bflo(unsigned w) { return __uint_as_float(w << 16); }
__device__ __forceinline__ float bfhi(unsigned w) { return __uint_as_float(w & 0xffff0000u); }

constexpr size_t MiB = 1u << 20;
constexpr size_t WS_CTL = 0, CTL_ZERO_BYTES = 2 * MiB;
constexpr size_t WS_ROWSQ = 512 * 1024;
constexpr size_t WS_WIN = 2 * MiB, WS_WPA = 16 * MiB, WS_WPR = 18 * MiB, WS_WOUT = 20 * MiB, WS_WUP = 22 * MiB, WS_WDN = 30 * MiB;
constexpr size_t WS_WGA = 38 * MiB, WS_WGX = WS_WGA + 256 * 1024;
constexpr size_t WS_B0 = 48 * MiB, BST = 56 * MiB, SEC = 8 * MiB;
constexpr size_t O_Q = 0, O_K = SEC, O_V = 2 * SEC, O_XR = 3 * SEC, O_GG = 4 * SEC, O_SGA = 5 * SEC, O_SGR = 6 * SEC;
constexpr size_t O_XN2 = O_Q;
constexpr size_t O_MERGED = O_SGR;
constexpr size_t O_UP = O_K;
constexpr size_t WS_END = WS_B0 + 8 * BST;
constexpr size_t DBS = 16 * MiB, DO_R = 8 * MiB;
constexpr int CW_BAR = 4096, CW_QBAR = 262144;

constexpr int RING_OFF = 0, RING_BYTES = 131072;
constexpr int LDSCTL_OFF = 161024, MISC_OFF = LDSCTL_OFF + 320;
constexpr int LDS_BYTES = 163840;

#define XB_TMO      128
#define XB_XCNT(j)  (256  + 64 * (j))
#define XB_XSUB(j)  (1280 + 64 * (j))
#define XB_XGEN(j)  (2304 + 64 * (j))
#define XB_TOP      3328
#define XB_TOPGEN   3392
#define XCD_BAR_WORDS 3456
#define XB_SPIN_CAP (1u << 18)
__device__ __forceinline__ unsigned xb_ld(unsigned* p)              { return __hip_atomic_load(p, __ATOMIC_RELAXED, __HIP_MEMORY_SCOPE_AGENT); }
__device__ __forceinline__ unsigned xb_add(unsigned* p, unsigned v) { return __hip_atomic_fetch_add(p, v, __ATOMIC_RELAXED, __HIP_MEMORY_SCOPE_AGENT); }
__device__ __forceinline__ unsigned xb_xcc_id() { return (unsigned)__builtin_amdgcn_s_getreg((3 << 11) | 20) & 0xFu; }
#define XB_SPIN(cond, bar) do { unsigned _sp = 0; while (cond) { __builtin_amdgcn_s_sleep(1); \
    if ((++_sp & 255u) == 0u) { if (xb_ld(&(bar)[XB_TMO])) break; if (_sp > XB_SPIN_CAP) { atomicAdd(&(bar)[XB_TMO], 1u); break; } } } } while (0)
struct XcdBarrier { unsigned* bar; unsigned x; volatile LAS unsigned* st; unsigned members; };
__device__ __forceinline__ XcdBarrier xcd_barrier_post(unsigned* bar, volatile LAS unsigned* st, unsigned members) {
    XcdBarrier b; b.bar = bar; b.x = xb_xcc_id(); b.st = st; b.members = members;
    if (threadIdx.x == 0) (void)xb_add(&bar[XB_XCNT(b.x)], 1u);
    return b;
}
__device__ __forceinline__ void xcd_barrier_complete(unsigned* bar, unsigned x, unsigned G, unsigned& nloc, unsigned& nx) {
    unsigned sum, cnt, mine, sp = 0u;
    for (;;) {
        sum = 0u; cnt = 0u; mine = 0u;
#pragma unroll
        for (unsigned j = 0; j < 16; ++j) { const unsigned c = xb_ld(&bar[XB_XCNT(j)]); sum += c; cnt += (c > 0u) ? 1u : 0u; mine = (j == x) ? c : mine; }
        if (sum == G) break;
        __builtin_amdgcn_s_sleep(1);
        if ((++sp & 255u) == 0u) { if (xb_ld(&bar[XB_TMO])) break; if (sp > XB_SPIN_CAP) { atomicAdd(&bar[XB_TMO], 1u); break; } }
    }
    nloc = mine > 0u ? mine : 1u; nx = cnt > 0u ? cnt : 1u;
}
__device__ __forceinline__ void xcd_barrier(const XcdBarrier& b) {
    asm volatile("s_waitcnt vmcnt(0)" ::: "memory");
    __syncthreads();
    if (threadIdx.x == 0) {
        unsigned* bar = b.bar;
        __builtin_amdgcn_s_waitcnt(0);
        unsigned nloc = b.st[0], nx = b.st[1];
        if (nloc == 0u) { xcd_barrier_complete(bar, b.x, b.members, nloc, nx); b.st[0] = nloc; b.st[1] = nx; }
        const unsigned old = xb_add(&bar[XB_XSUB(b.x)], 1u);
        const unsigned gen = old / nloc;
        if (old + 1u == (gen + 1u) * nloc) {
            __builtin_amdgcn_fence(__ATOMIC_RELEASE, "agent");
            asm volatile("s_waitcnt vmcnt(0)" ::: "memory");
            const unsigned og = xb_add(&bar[XB_TOP], 1u);
            const unsigned tg = og / nx;
            if (og + 1u == (tg + 1u) * nx) xb_add(&bar[XB_TOPGEN], 1u);
            else XB_SPIN(xb_ld(&bar[XB_TOPGEN]) == tg, bar);
            __builtin_amdgcn_fence(__ATOMIC_ACQUIRE, "agent");
            xb_add(&bar[XB_XGEN(b.x)], 1u);
            asm volatile("s_waitcnt vmcnt(0)" ::: "memory");
        } else {
            XB_SPIN(xb_ld(&bar[XB_XGEN(b.x)]) == gen, bar);
            __builtin_amdgcn_fence(__ATOMIC_ACQUIRE, "agent");
            asm volatile("s_waitcnt vmcnt(0)" ::: "memory");
        }
    }
    __syncthreads();
}

constexpr int NWAVES = 8;
struct Frame {
    LAS unsigned char* lds;
    volatile LAS unsigned* MISC;
    gu32* ctl;
    int tid, lane, wave, vcu, G;
    const float* in[24];
    float* out; unsigned char* ws;
};

__device__ __forceinline__ float wave_sum(float v) {
#pragma unroll
    for (int o = 1; o < 64; o <<= 1) v += __shfl_xor(v, o);
    return v;
}

__device__ __forceinline__ void p0_transpose_item(const float* W, int K, int N, bf16* WT, LAS float* scr, int item, int lane, const float* kscale, bool remap) {
    const int nblk = N / 32, kb = item / nblk, nb = item % nblk, k0 = 64 * kb, n0 = 32 * nb;
    f32x4 v[8];
#pragma unroll
    for (int i = 0; i < 8; ++i) v[i] = __builtin_nontemporal_load((const GAS f32x4*)(W + (size_t)(k0 + 8 * i + (lane >> 3)) * N + n0 + 4 * (lane & 7)));
#pragma unroll
    for (int i = 0; i < 8; ++i) { const int kk = 8 * i + (lane >> 3); f32x4 x = v[i]; if (kscale) x = x * kscale[k0 + kk];
        LAS float* d = scr + kk * 33 + 4 * (lane & 7); d[0] = x.x; d[1] = x.y; d[2] = x.z; d[3] = x.w; }
    LDS_WAIT(); asm volatile("" ::: "memory");
    int slot0 = n0;
    if (remap && n0 < 2048) { const int ls = n0 & 255, wc = ls >> 6, bj = (ls >> 5) & 1; slot0 = (n0 & ~255) + 128 * bj + 32 * wc; }
    const int c = lane & 7;
#pragma unroll
    for (int j = 0; j < 4; ++j) { const int n = (lane >> 3) + 8 * j; const LAS float* sp = scr + (8 * c) * 33 + n;
        v4u o; o.x = pk2(sp[0 * 33], sp[1 * 33]); o.y = pk2(sp[2 * 33], sp[3 * 33]); o.z = pk2(sp[4 * 33], sp[5 * 33]); o.w = pk2(sp[6 * 33], sp[7 * 33]);
        *(GAS v4u*)(WT + (size_t)(slot0 + n) * K + k0 + 8 * c) = o; }
    LDS_WAIT(); asm volatile("" ::: "memory");
}
__device__ __forceinline__ void rms_rows4_to_bf16(int lane, const float* xrow, const float* g, bf16* orow) {
    f32x4 v[4][4];
#pragma unroll
    for (int r = 0; r < 4; ++r)
#pragma unroll
        for (int j = 0; j < 4; ++j) v[r][j] = __builtin_nontemporal_load((const GAS f32x4*)(xrow + (size_t)r * DM) + lane + 64 * j);
    f32x4 gg[4];
#pragma unroll
    for (int j = 0; j < 4; ++j) gg[j] = *((const GAS f32x4*)g + lane + 64 * j);
#pragma unroll
    for (int r = 0; r < 4; ++r) { float s = 0.f;
#pragma unroll
        for (int j = 0; j < 4; ++j) s += (v[r][j].x * v[r][j].x + v[r][j].y * v[r][j].y) + (v[r][j].z * v[r][j].z + v[r][j].w * v[r][j].w);
        const float rinv = __builtin_amdgcn_rsqf(wave_sum(s) * (1.f / DM) + EPS);
        GAS unsigned long long* o8 = (GAS unsigned long long*)(orow + (size_t)r * DM) + lane;
#pragma unroll
        for (int j = 0; j < 4; ++j) { const f32x4 y = v[r][j] * rinv * gg[j]; o8[64 * j] = (unsigned long long)pk2(y.x, y.y) | ((unsigned long long)pk2(y.z, y.w) << 32); } }
}
__device__ __forceinline__ void p0_prologue(Frame& F, const int parts = 3) {
    LAS float* scr = (LAS float*)(F.lds + RING_OFF + F.wave * 16384);
    const int gw = F.vcu * NWAVES + F.wave, NGW = F.G * NWAVES;
    bf16* Win_t = (bf16*)(F.ws + WS_WIN); bf16* Wpa_t = (bf16*)(F.ws + WS_WPA); bf16* Wpr_t = (bf16*)(F.ws + WS_WPR); bf16* Wout_t = (bf16*)(F.ws + WS_WOUT);
    bf16* Wup_t = (bf16*)(F.ws + WS_WUP); bf16* Wdn_t = (bf16*)(F.ws + WS_WDN); bf16* Wga_t = (bf16*)(F.ws + WS_WGA); bf16* Wgx_t = (bf16*)(F.ws + WS_WGX);
    constexpr int I_IN = (DM / 64) * (NIN / 32), I_SQ = (DM / 64) * (DM / 32), I_UP = (DM / 64) * (FF / 32), I_DN = (FF / 64) * (DM / 32), I_G = 2 * 4;
    constexpr int NITEMS = I_IN + 3 * I_SQ + I_UP + I_DN + 16 * I_G;
    if (parts & 1) for (int it = gw; it < NITEMS; it += NGW) {
        int r = it;
        if (r < I_IN) { p0_transpose_item(F.in[2], DM, NIN, Win_t, scr, r, F.lane, nullptr, true); continue; } r -= I_IN;
        if (r < I_SQ) { p0_transpose_item(F.in[17], DM, DM, Wpa_t, scr, r, F.lane, nullptr, false); continue; } r -= I_SQ;
        if (r < I_SQ) { p0_transpose_item(F.in[18], DM, DM, Wpr_t, scr, r, F.lane, nullptr, false); continue; } r -= I_SQ;
        if (r < I_SQ) { p0_transpose_item(F.in[19], DM, DM, Wout_t, scr, r, F.lane, nullptr, false); continue; } r -= I_SQ;
        if (r < I_UP) { p0_transpose_item(F.in[21], DM, FF, Wup_t, scr, r, F.lane, F.in[20], false); continue; } r -= I_UP;
        if (r < I_DN) { p0_transpose_item(F.in[22], FF, DM, Wdn_t, scr, r, F.lane, nullptr, false); continue; } r -= I_DN;
        { const int blk = r / I_G, sub = r % I_G;
          const float* W = (blk < 8 ? F.in[12] : F.in[14]) + (size_t)(blk & 7) * 16384; bf16* WT = (blk < 8 ? Wga_t : Wgx_t) + (size_t)(blk & 7) * 16384;
          p0_transpose_item(W, 128, 128, WT, scr, sub, F.lane, nullptr, false); }
    }
    bf16* XN = (bf16*)F.out;
    if (parts & 2) for (int m = 4 * gw; m < M; m += 4 * NGW) rms_rows4_to_bf16(F.lane, F.in[0] + (size_t)m * DM, F.in[1], XN + (size_t)(m >> 12) * (DBS / 2) + (size_t)(m & 4095) * DM);
}

namespace lru {
constexpr int TS = 128, NST = SEQ / TS, NITEMS = BATCH * 8 * 4;
constexpr int XS = 272;
constexpr int IMG_BYTES = TS * XS;
constexpr int HS = 80;
constexpr int L_IMG = 0, L_HL = 2 * IMG_BYTES, L_SUM = L_HL + 2 * TS * HS, L_END = L_SUM + 2 * 1024;
static_assert(L_END <= RING_BYTES, "lru lds");
typedef float f32x4_t __attribute__((ext_vector_type(4)));
__device__ __forceinline__ float shfl_from(float x, int src) { return __uint_as_float((unsigned)__builtin_amdgcn_ds_bpermute(src << 2, (int)__float_as_uint(x))); }

__device__ __forceinline__ void item(Frame& F, int it) {
    const int b = it >> 5, blk = (it >> 2) & 7, oc = it & 3;
    const int tid = F.tid, lane = F.lane, w = F.wave;
    const bf16* XR = (const bf16*)(F.ws + WS_B0 + (size_t)b * BST + O_XR); const bf16* GG = (const bf16*)(F.ws + WS_B0 + (size_t)b * BST + O_GG);
    bf16* R = (bf16*)((unsigned char*)F.out + (size_t)b * DBS + DO_R);
    LAS unsigned char* L = F.lds + RING_OFF;
    const int rbw = w & 3, cbw = w >> 2, f = lane & 15, kq = lane >> 4;
    const int cib = oc * 32 + cbw * 16 + f, gch = blk * 128 + cib;
    const float nba = -LOG2E * F.in[13][gch], nbx = -LOG2E * F.in[15][gch];
    const float sp8 = 8.0f * log1pf(expf(-F.in[16][gch]));
    const float k_a = -sp8 * LOG2E;
    bf16x8 Ba[4], Bx[4];
    { const bf16* wa = (const bf16*)(F.ws + WS_WGA) + (size_t)blk * 16384 + cib * 128 + 8 * kq; const bf16* wx = (const bf16*)(F.ws + WS_WGX) + (size_t)blk * 16384 + cib * 128 + 8 * kq;
#pragma unroll
      for (int ks = 0; ks < 4; ++ks) { Ba[ks] = *(const bf16x8*)(wa + ks * 32); Bx[ks] = *(const bf16x8*)(wx + ks * 32); } }
    const int cg = tid & 15, tq = tid >> 4, cch = blk * 128 + cg * 8;
    f32x2_c cw2[4][4], cb2[4];
#pragma unroll
    for (int p = 0; p < 4; ++p) { cb2[p] = (f32x2_c){F.in[11][cch + 2 * p], F.in[11][cch + 2 * p + 1]};
#pragma unroll
        for (int j = 0; j < 4; ++j) cw2[j][p] = (f32x2_c){F.in[10][j * DM + cch + 2 * p], F.in[10][j * DM + cch + 2 * p + 1]}; }
    const bf16* xrp = XR + cch;
    const int ott = tid >> 2, opart = tid & 3;
    const size_t ooff = (size_t)ott * DM + blk * 128 + oc * 32 + opart * 8;
    v4u xv[7];
#define LRU_LOAD(t0_) do { _Pragma("unroll") for (int j = 0; j < 7; ++j) { const int tr = (t0_) + 4 * tq - 3 + j; xv[j] = tr >= 0 ? *(const v4u*)(xrp + (size_t)tr * DM) : (v4u){0u, 0u, 0u, 0u}; } } while (0)
    LRU_LOAD(0);
    float hc = 0.f;
    float av[2][4], bv[2][4], Ae[2], He[2], At[2], Ht[2];
    float pav[2][4], pbv[2][4], pAe[2], pHe[2], pAt[2], pHt[2];
    v4u gv0 = (v4u){0u, 0u, 0u, 0u}, gv1 = gv0, gv2 = gv0;
#pragma unroll 1
    for (int st = 0; st < NST + 2; ++st) {
        const int t0 = st * TS;
        LAS unsigned char* img = L + L_IMG + (st & 1) * IMG_BYTES;
        if (st < NST) {
            f32x2_c fr[7][4];
#pragma unroll
            for (int j = 0; j < 7; ++j) { fr[j][0] = (f32x2_c){bflo(xv[j].x), bfhi(xv[j].x)}; fr[j][1] = (f32x2_c){bflo(xv[j].y), bfhi(xv[j].y)}; fr[j][2] = (f32x2_c){bflo(xv[j].z), bfhi(xv[j].z)}; fr[j][3] = (f32x2_c){bflo(xv[j].w), bfhi(xv[j].w)}; }
#pragma unroll
            for (int tk = 0; tk < 4; ++tk) { f32x2_c xc[4];
#pragma unroll
                for (int p = 0; p < 4; ++p) xc[p] = __builtin_elementwise_fma(cw2[3][p], fr[tk + 3][p], __builtin_elementwise_fma(cw2[2][p], fr[tk + 2][p], __builtin_elementwise_fma(cw2[1][p], fr[tk + 1][p], __builtin_elementwise_fma(cw2[0][p], fr[tk][p], cb2[p]))));
                v4u pw; pw.x = pk2(xc[0].x, xc[0].y); pw.y = pk2(xc[1].x, xc[1].y); pw.z = pk2(xc[2].x, xc[2].y); pw.w = pk2(xc[3].x, xc[3].y);
                *(LAS v4u*)(img + (4 * tq + tk) * XS + cg * 16) = pw; }
            if (st + 1 < NST) LRU_LOAD(t0 + TS);
            gv0 = *(const v4u*)(GG + ooff + (size_t)t0 * DM);
        }
        LDS_WAIT(); __builtin_amdgcn_s_barrier(); asm volatile("" ::: "memory");
        if (st >= 2) {
            const v4u hv = *(const LAS v4u*)(L + L_HL + (st & 1) * (TS * HS) + ott * HS + opart * 16);
            v4u o; o.x = pk2(bflo(hv.x) * bflo(gv2.x), bfhi(hv.x) * bfhi(gv2.x)); o.y = pk2(bflo(hv.y) * bflo(gv2.y), bfhi(hv.y) * bfhi(gv2.y));
            o.z = pk2(bflo(hv.z) * bflo(gv2.z), bfhi(hv.z) * bfhi(gv2.z)); o.w = pk2(bflo(hv.w) * bflo(gv2.w), bfhi(hv.w) * bfhi(gv2.w));
            *(v4u*)(R + ooff + (size_t)(t0 - 2 * TS) * DM) = o;
        }
        if (st >= 1 && st <= NST) {
            const LAS float* sum = (const LAS float*)(L + L_SUM + ((st - 1) & 1) * 1024);
            LAS unsigned char* hl = L + L_HL + ((st - 1) & 1) * (TS * HS);
            float cin = hc;
#pragma unroll
            for (int rb = 0; rb < 4; ++rb) { const float Aw = sum[((cbw * 4 + rb) * 16 + f) * 2], Hw = sum[((cbw * 4 + rb) * 16 + f) * 2 + 1];
                hc = Aw * hc + Hw; if (rb < rbw) cin = hc; }
#pragma unroll
            for (int sg = 0; sg < 2; ++sg) { float hh = pAe[sg] * cin + pHe[sg];
#pragma unroll
                for (int rg = 0; rg < 4; ++rg) { hh = pav[sg][rg] * hh + pbv[sg][rg];
                    *(LAS unsigned short*)(hl + (32 * rbw + 16 * sg + 4 * kq + rg) * HS + (cbw * 16 + f) * 2) = (unsigned short)f2bf(hh); }
                cin = pAt[sg] * cin + pHt[sg]; }
        }
        if (st < NST) {
            LAS float* sum = (LAS float*)(L + L_SUM + (st & 1) * 1024);
            f32x4_t gaa[2], gxx[2]; bf16x8 af[2][4];
#pragma unroll
            for (int sg = 0; sg < 2; ++sg) { gaa[sg] = (f32x4_t){0.f, 0.f, 0.f, 0.f}; gxx[sg] = (f32x4_t){0.f, 0.f, 0.f, 0.f};
#pragma unroll
                for (int ks = 0; ks < 4; ++ks) af[sg][ks] = *(const LAS bf16x8*)(img + (32 * rbw + 16 * sg + f) * XS + (ks * 32 + 8 * kq) * 2); }
#pragma unroll
            for (int ks = 0; ks < 4; ++ks)
#pragma unroll
                for (int sg = 0; sg < 2; ++sg) { gaa[sg] = __builtin_amdgcn_mfma_f32_16x16x32_bf16(af[sg][ks], Ba[ks], gaa[sg], 0, 0, 0); gxx[sg] = __builtin_amdgcn_mfma_f32_16x16x32_bf16(af[sg][ks], Bx[ks], gxx[sg], 0, 0, 0); }
#pragma unroll
            for (int sg = 0; sg < 2; ++sg) { const int row0 = 32 * rbw + 16 * sg;
                const f32x4_t ga = gaa[sg], gx = gxx[sg];
#pragma unroll
                for (int rg = 0; rg < 4; ++rg) {
                    const float xc = __uint_as_float((unsigned)(*(const LAS unsigned short*)(img + (row0 + 4 * kq + rg) * XS + cib * 2)) << 16);
                    const float r = __builtin_amdgcn_rcpf(1.0f + __builtin_amdgcn_exp2f(__builtin_fmaf(ga[rg], -LOG2E, nba)));
                    const float iv = __builtin_amdgcn_rcpf(1.0f + __builtin_amdgcn_exp2f(__builtin_fmaf(gx[rg], -LOG2E, nbx)));
                    const float a = __builtin_amdgcn_exp2f(r * k_a);
                    const float m1 = __builtin_fmaf(-a, a, 1.0f);
                    av[sg][rg] = a; bv[sg][rg] = __builtin_amdgcn_sqrtf(m1) * (iv * xc); }
                float A = av[sg][0], H = bv[sg][0];
#pragma unroll
                for (int j = 1; j < 4; ++j) { H = av[sg][j] * H + bv[sg][j]; A *= av[sg][j]; }
                { const auto pa = __builtin_amdgcn_permlane16_swap(__float_as_uint(A), __float_as_uint(A), false, false), ph = __builtin_amdgcn_permlane16_swap(__float_as_uint(H), __float_as_uint(H), false, false);
                  const auto qa0 = __builtin_amdgcn_permlane32_swap(pa[0], pa[0], false, false), qa1 = __builtin_amdgcn_permlane32_swap(pa[1], pa[1], false, false);
                  const auto qh0 = __builtin_amdgcn_permlane32_swap(ph[0], ph[0], false, false), qh1 = __builtin_amdgcn_permlane32_swap(ph[1], ph[1], false, false);
                  const float A0 = __uint_as_float(qa0[0]), A2 = __uint_as_float(qa0[1]), A1 = __uint_as_float(qa1[0]), A3 = __uint_as_float(qa1[1]);
                  const float H0 = __uint_as_float(qh0[0]), H2 = __uint_as_float(qh0[1]), H1 = __uint_as_float(qh1[0]), H3 = __uint_as_float(qh1[1]);
                  const float A01 = A1 * A0, H01 = A1 * H0 + H1, A012 = A2 * A01, H012 = A2 * H01 + H2;
                  At[sg] = A3 * A012; Ht[sg] = A3 * H012 + H3;
                  Ae[sg] = kq == 0 ? 1.f : kq == 1 ? A0 : kq == 2 ? A01 : A012; He[sg] = kq == 0 ? 0.f : kq == 1 ? H0 : kq == 2 ? H01 : H012; } }
            if (kq == 0) { sum[((cbw * 4 + rbw) * 16 + f) * 2] = At[1] * At[0]; sum[((cbw * 4 + rbw) * 16 + f) * 2 + 1] = At[1] * Ht[0] + Ht[1]; }
        }
#pragma unroll
        for (int sg = 0; sg < 2; ++sg) { pAe[sg] = Ae[sg]; pHe[sg] = He[sg]; pAt[sg] = At[sg]; pHt[sg] = Ht[sg];
#pragma unroll
            for (int rg = 0; rg < 4; ++rg) { pav[sg][rg] = av[sg][rg]; pbv[sg][rg] = bv[sg][rg]; } }
        gv2 = gv1; gv1 = gv0;
    }
#undef LRU_LOAD
    LDS_WAIT(); __builtin_amdgcn_s_barrier(); asm volatile("" ::: "memory");
}
__device__ __forceinline__ void phase(Frame& F) { for (int it = F.vcu; it < NITEMS; it += F.G) item(F, it); }
}

namespace att {
constexpr int SLOTK = 8192, SLOTV = 16384;
constexpr int L_K = 0, L_V = 4 * SLOTK, L_STG = L_V + 3 * SLOTV, L_WS = L_STG + 8 * 8192, L_TAB = L_WS + 8 * 256, TABN = 704, TSTR = 720, TREL = 447, L_END = L_TAB + 4 * TSTR * 4;
static_assert(L_END <= LDSCTL_OFF, "attention lds");
typedef LAS const char* lds_cptr;
typedef short v4i16_t __attribute__((ext_vector_type(4)));
typedef float f32x2_t __attribute__((ext_vector_type(2))); typedef __bf16 bf16x2_t __attribute__((ext_vector_type(2)));
#define SBAR() __builtin_amdgcn_sched_barrier(0)
#define PIN(x) asm volatile("" : "+v"(x))
#define MF(a, b, c) __builtin_amdgcn_mfma_f32_32x32x16_bf16(a, b, c, 0, 0, 0)
#define WAIT_BAR(N) asm volatile("s_waitcnt vmcnt(" #N ") lgkmcnt(0)\n\ts_barrier" ::: "memory")
__device__ __forceinline__ int crow(int r, int hi) { return (r & 3) + 8 * (r >> 2) + 4 * hi; }
__device__ __forceinline__ void glds16(const void* gsrc, unsigned lds_dst) { unsigned keep;
    asm volatile("s_mov_b32 %0, m0\n\ts_mov_b32 m0, %2\n\ts_nop 0\n\tglobal_load_lds_dwordx4 %1, off\n\ts_mov_b32 m0, %0" : "=&s"(keep) : "v"(gsrc), "s"(lds_dst) : "memory"); }
__device__ __forceinline__ unsigned cvtpk_s(float lo, float hi) { f32x2_t v = {lo, hi}; bf16x2_t b = __builtin_convertvector(v, bf16x2_t); return __builtin_bit_cast(unsigned, b); }
__device__ __forceinline__ void kload2(bf16x8* kf, lds_cptr kp, int d0) { kf[2 * d0] = *(const LAS bf16x8*)(kp + d0 * 2048); kf[2 * d0 + 1] = *(const LAS bf16x8*)(kp + d0 * 2048 + 512); }
__device__ __forceinline__ s16x4 vtr(lds_cptr p) { return __builtin_bit_cast(s16x4, __builtin_amdgcn_ds_read_tr16_b64_v4i16((LAS v4i16_t*)p)); }
__device__ __forceinline__ int bucket_of(int n) {
    if (n < 16) return n;
    int bk = 16;
    bk += (n >= 19); bk += (n >= 21); bk += (n >= 24); bk += (n >= 27); bk += (n >= 31); bk += (n >= 35); bk += (n >= 40); bk += (n >= 46);
    bk += (n >= 52); bk += (n >= 59); bk += (n >= 67); bk += (n >= 77); bk += (n >= 87); bk += (n >= 99); bk += (n >= 113);
    return bk;
}
__device__ __forceinline__ void bias_init(f32x16& p0, f32x16& p1, const LAS char* bp) {
    typedef float f32x4_t __attribute__((ext_vector_type(4)));
    const f32x4_t a0 = *(const LAS f32x4_t*)(bp), a1 = *(const LAS f32x4_t*)(bp + 32), a2 = *(const LAS f32x4_t*)(bp + 64), a3 = *(const LAS f32x4_t*)(bp + 96);
    const f32x4_t b0 = *(const LAS f32x4_t*)(bp + 128), b1 = *(const LAS f32x4_t*)(bp + 160), b2 = *(const LAS f32x4_t*)(bp + 192), b3 = *(const LAS f32x4_t*)(bp + 224);
    p0 = (f32x16){a0[0], a0[1], a0[2], a0[3], a1[0], a1[1], a1[2], a1[3], a2[0], a2[1], a2[2], a2[3], a3[0], a3[1], a3[2], a3[3]};
    p1 = (f32x16){b0[0], b0[1], b0[2], b0[3], b1[0], b1[1], b1[2], b1[3], b2[0], b2[1], b2[2], b2[3], b3[0], b3[1], b3[2], b3[3]};
}
__device__ __forceinline__ void pv(f32x16* o, int vb, bf16x8 pa0, bf16x8 pa1, bf16x8 pa2, bf16x8 pa3) {
#pragma unroll
    for (int d0 = 0; d0 < 4; ++d0) { s16x4 lo[4], hi[4];
#pragma unroll
        for (int ks = 0; ks < 4; ++ks) {
            asm volatile("ds_read_b64_tr_b16 %0,%1 offset:%c2" : "=&v"(lo[ks]) : "v"(vb), "i"(d0 * 4096 + ks * 1024) : "memory");
            asm volatile("ds_read_b64_tr_b16 %0,%1 offset:%c2" : "=&v"(hi[ks]) : "v"(vb), "i"(d0 * 4096 + ks * 1024 + 512) : "memory"); }
        asm volatile("s_waitcnt lgkmcnt(0)" ::: "memory"); SBAR();
#define PK(k) (bf16x8){lo[k][0], lo[k][1], lo[k][2], lo[k][3], hi[k][0], hi[k][1], hi[k][2], hi[k][3]}
        o[d0] = MF(pa0, PK(0), o[d0]); o[d0] = MF(pa1, PK(1), o[d0]); o[d0] = MF(pa2, PK(2), o[d0]); o[d0] = MF(pa3, PK(3), o[d0]);
#undef PK
    }
}

struct PassSrc { const bf16* ksrc; const bf16* vsrc; const bf16* qw; };
__device__ __forceinline__ PassSrc pass_src(int b, int h, int qb, int c, const bf16* Q, const bf16* K, const bf16* V, int lane, int wid) {
    const size_t bb = (size_t)b * (BST / 2); PassSrc p;
    p.ksrc = K + bb + h * 128 + c * 64 + (long)lane * DM + wid * 8;
    p.vsrc = V + bb + h * 128 + (long)(16 * (wid & 3) + (lane >> 2)) * DM + (wid >> 2) * 32 + (lane & 3) * 8;
    p.qw = Q + bb + (long)(qb * 256 + wid * 32 + (lane & 31)) * DM + h * 128 + c * 64 + (lane >> 5) * 8;
    return p;
}
#define ATT_DMA_K(src, t) glds16((src) + (long)(t) * 64 * DM, (unsigned)__builtin_amdgcn_readfirstlane(kdst + ((t) & 3) * SLOTK))
#define ATT_DMA_V(src, t, voff) do { glds16((src) + (long)(t) * 64 * DM, (unsigned)__builtin_amdgcn_readfirstlane(vdst + (voff))); \
                                     glds16((src) + (long)(t) * 64 * DM + 64, (unsigned)__builtin_amdgcn_readfirstlane(vdst + (voff) + 8192)); } while (0)

__device__ __forceinline__ void apass(int b, int h, int qb, int c, bool first, bool has_next, const PassSrc nx, const bf16* K, const bf16* V, bf16* O, LAS unsigned char* lds, float lam,
                                      const float* rel_bias, const float* subln_g, bf16x8 (&qr)[4], int& sl_prev, int& sl_cur, int& sl_next) {
    const int tid = threadIdx.x, lane = tid & 63, r32 = lane & 31, hi = lane >> 5; const int wid = __builtin_amdgcn_readfirstlane(tid >> 6);
    const int q0 = qb * 256, NT = 4 * qb + 4;
    const unsigned lds0 = (unsigned)(uintptr_t)lds;
    LAS float* wsf = (LAS float*)(lds + L_WS) + wid * 64;
    LAS float* tab = (LAS float*)(lds + L_TAB);
    LAS unsigned short* stg = (LAS unsigned short*)(lds + L_STG) + wid * 4096;
    const int qpos = q0 + wid * 32 + r32;
    const int vb0 = (int)(lds0 + L_V) + ((lane >> 4) & 1) * 32 + (lane & 3) * 8 + (4 * hi + ((lane & 15) >> 2)) * 64;
    const lds_cptr vp0 = (lds_cptr)(lds + L_V) + ((lane >> 4) & 1) * 32 + (lane & 3) * 8 + (4 * hi + ((lane & 15) >> 2)) * 64;
    const lds_cptr kp0 = (lds_cptr)(lds + L_K) + hi * 1024 + r32 * 16;
    const f32x16 ZERO = f32x16{};
    const unsigned kdst = lds0 + L_K + wid * 1024, vdst = lds0 + L_V + wid * 1024;
#define ROT() do { sl_prev = sl_cur; sl_cur = sl_next; sl_next = (sl_next == 2 * SLOTV) ? 0 : sl_next + SLOTV; } while (0)
    if (!first) ROT();
    if (c == 0) {
        const float b31 = rel_bias[31 * NH + h];
        for (int j = tid; j < TABN; j += 512) { const int rel = TREL - j;
            const float v = rel < 0 ? -INFINITY : (rel < 113 ? (rel_bias[bucket_of(rel) * NH + h] - b31) * LOG2E : 0.f);
#pragma unroll
            for (int cc = 0; cc < 4; ++cc) if (j - cc >= 0) tab[cc * TSTR + j - cc] = v; }
        asm volatile("s_waitcnt lgkmcnt(0)\n\ts_barrier" ::: "memory"); }
    const int cpy = (3 - qpos) & 3;
    const LAS char* tabl = (const LAS char*)tab + cpy * (TSTR * 4) + 4 * (TREL - qpos + 4 * hi - cpy);
    {
        const PassSrc cu = pass_src(b, h, qb, c, nullptr, K, V, lane, wid);
        const bf16* ksrc = cu.ksrc; const bf16* vsrc = cu.vsrc;
#define DMA_K(t) ATT_DMA_K(ksrc, t)
#define DMA_V(t, voff) ATT_DMA_V(vsrc, t, voff)
        f32x16 o[4];
#pragma unroll
        for (int d0 = 0; d0 < 4; ++d0) o[d0] = f32x16{};
        float l_reg = 0.f;
        f32x16 pA0, pA1, pB0, pB1; bf16x8 kf[8]; s16x4 vlo[3], vhi[3]; v4u pw0, pw1, pw2, pw3;
#define EX(v) __builtin_amdgcn_exp2f(v)
#define PKW(P, i) cvtpk_s(P[i], P[(i) + 1])
#pragma unroll
        for (int d0 = 0; d0 < 4; ++d0) kload2(kf, kp0, d0);
        if (NT <= 6) { bias_init(pA0, pA1, tabl); pA0 = MF(kf[0], qr[0], pA0); pA1 = MF(kf[1], qr[0], pA1); }
        else { pA0 = MF(kf[0], qr[0], ZERO); pA1 = MF(kf[1], qr[0], ZERO); }
        pA0 = MF(kf[2], qr[1], pA0); pA1 = MF(kf[3], qr[1], pA1);
        pA0 = MF(kf[4], qr[2], pA0); pA1 = MF(kf[5], qr[2], pA1); pA0 = MF(kf[6], qr[3], pA0); pA1 = MF(kf[7], qr[3], pA1);
#pragma unroll
        for (int r = 0; r < 16; ++r) { pA0[r] = EX(pA0[r]); pA1[r] = EX(pA1[r]); }
        asm volatile("s_waitcnt lgkmcnt(0)\n\ts_barrier" ::: "memory");
        DMA_K(3); DMA_V(1, sl_next); ROT();
        kload2(kf, kp0 + SLOTK, 0); kload2(kf, kp0 + SLOTK, 1);
#define PAF(k) __builtin_bit_cast(bf16x8, pw##k)
#define VFR(i) (bf16x8){vlo[(i) % 3][0], vlo[(i) % 3][1], vlo[(i) % 3][2], vlo[(i) % 3][3], vhi[(i) % 3][0], vhi[(i) % 3][1], vhi[(i) % 3][2], vhi[(i) % 3][3]}
#define VRD(i) do { vlo[(i) % 3] = vtr(vp_ + (((i) & 3) * 4096 + ((i) >> 2) * 1024)); vhi[(i) % 3] = vtr(vp_ + (((i) & 3) * 4096 + ((i) >> 2) * 1024 + 512)); } while (0)
#define KRD(G, d0) do { if (G) { kload2(kf, knx_, d0); } } while (0)
#define GAPA(MFX, a0, a1, a2, a3, W0, W1, PW) do { MFX; sacc += a0; sacc += a1; sacc += a2; sacc += a3; W0; W1; PIN(PW); PIN(sacc); SBAR(); } while (0)
#define GAPB(MFX, X, i) do { MFX; X[i] = EX(X[i]); X[(i) + 1] = EX(X[(i) + 1]); PIN(X); SBAR(); } while (0)
#define STEP(C0, C1, P0, P1, t, BANDF, GK, GV, GL) do { SBAR(); \
    const lds_cptr vp_ = vp0 + sl_prev; const lds_cptr kcu_ = kp0 + ((t) & 3) * SLOTK; const lds_cptr knx_ = kp0 + (((t) + 1) & 3) * SLOTK; \
    if (BANDF) { bias_init(C0, C1, tabl + (t) * 256); } \
    kload2(kf, kcu_, 2); kload2(kf, kcu_, 3); \
    float sacc = P0[0] + P0[1]; SBAR(); \
    if (BANDF) { GAPA(C0 = MF(kf[0], qr[0], C0),   P0[2], P0[3], P0[4], P0[5],     pw0[0] = PKW(P0, 0),  pw0[1] = PKW(P0, 2),  pw0); \
                 GAPA(C1 = MF(kf[1], qr[0], C1),   P0[6], P0[7], P0[8], P0[9],     pw0[2] = PKW(P0, 4),  pw0[3] = PKW(P0, 6),  pw0); } \
    else       { GAPA(C0 = MF(kf[0], qr[0], ZERO), P0[2], P0[3], P0[4], P0[5],     pw0[0] = PKW(P0, 0),  pw0[1] = PKW(P0, 2),  pw0); \
                 GAPA(C1 = MF(kf[1], qr[0], ZERO), P0[6], P0[7], P0[8], P0[9],     pw0[2] = PKW(P0, 4),  pw0[3] = PKW(P0, 6),  pw0); } \
    GAPA(C0 = MF(kf[2], qr[1], C0),   P0[10], P0[11], P0[12], P0[13], pw1[0] = PKW(P0, 8),  pw1[1] = PKW(P0, 10), pw1); \
    GAPA(C1 = MF(kf[3], qr[1], C1),   P0[14], P0[15], P1[0], P1[1],   pw1[2] = PKW(P0, 12), pw1[3] = PKW(P0, 14), pw1); \
    GAPA(C0 = MF(kf[4], qr[2], C0),   P1[2], P1[3], P1[4], P1[5],     pw2[0] = PKW(P1, 0),  pw2[1] = PKW(P1, 2),  pw2); \
    GAPA(C1 = MF(kf[5], qr[2], C1),   P1[6], P1[7], P1[8], P1[9],     pw2[2] = PKW(P1, 4),  pw2[3] = PKW(P1, 6),  pw2); \
    VRD(0); SBAR(); GAPA(C0 = MF(kf[6], qr[3], C0), P1[10], P1[11], P1[12], P1[13], pw3[0] = PKW(P1, 8),  pw3[1] = PKW(P1, 10), pw3); \
    VRD(1); SBAR(); GAPA(C1 = MF(kf[7], qr[3], C1), P1[14], P1[15], 0.f, 0.f,       pw3[2] = PKW(P1, 12), pw3[3] = PKW(P1, 14), pw3); \
    l_reg += sacc; \
    if (GK) DMA_K((t) + 3); if (GV) DMA_V((t) + 1, sl_next); \
    SBAR(); \
    VRD(2);              SBAR(); GAPB(o[0] = MF(PAF(0), VFR(0),  o[0]), C0, 0); \
    VRD(3);              SBAR(); GAPB(o[1] = MF(PAF(0), VFR(1),  o[1]), C0, 2); \
    VRD(4);              SBAR(); GAPB(o[2] = MF(PAF(0), VFR(2),  o[2]), C0, 4); \
    VRD(5);              SBAR(); GAPB(o[3] = MF(PAF(0), VFR(3),  o[3]), C0, 6); \
    VRD(6);              SBAR(); GAPB(o[0] = MF(PAF(1), VFR(4),  o[0]), C0, 8); \
    VRD(7);  KRD(GL, 0); SBAR(); GAPB(o[1] = MF(PAF(1), VFR(5),  o[1]), C0, 10); \
    VRD(8);              SBAR(); GAPB(o[2] = MF(PAF(1), VFR(6),  o[2]), C0, 12); \
    VRD(9);              SBAR(); GAPB(o[3] = MF(PAF(1), VFR(7),  o[3]), C0, 14); \
    VRD(10);             SBAR(); GAPB(o[0] = MF(PAF(2), VFR(8),  o[0]), C1, 0); \
    VRD(11);             SBAR(); GAPB(o[1] = MF(PAF(2), VFR(9),  o[1]), C1, 2); \
    VRD(12);             SBAR(); GAPB(o[2] = MF(PAF(2), VFR(10), o[2]), C1, 4); \
    VRD(13); KRD(GL, 1); SBAR(); GAPB(o[3] = MF(PAF(2), VFR(11), o[3]), C1, 6); \
    VRD(14);             SBAR(); GAPB(o[0] = MF(PAF(3), VFR(12), o[0]), C1, 8); \
    VRD(15);             SBAR(); GAPB(o[1] = MF(PAF(3), VFR(13), o[1]), C1, 10); \
                                 GAPB(o[2] = MF(PAF(3), VFR(14), o[2]), C1, 12); \
                                 GAPB(o[3] = MF(PAF(3), VFR(15), o[3]), C1, 14); \
    } while (0)
        int t = 1;
        for (; t + 7 < NT; t += 2) {
            STEP(pB0, pB1, pA0, pA1, t, false, true, true, true);     WAIT_BAR(3); ROT();
            STEP(pA0, pA1, pB0, pB1, t + 1, false, true, true, true); WAIT_BAR(3); ROT();
        }
#define ENDW(tt) do { if ((tt) + 3 < NT) { WAIT_BAR(3); } else if ((tt) + 2 < NT) { WAIT_BAR(2); } else { WAIT_BAR(0); } } while (0)
        for (; t + 1 < NT; t += 2) {
            STEP(pB0, pB1, pA0, pA1, t, (t != NT - 7), (t + 3 < NT), (t + 1 < NT), (t + 1 < NT));     ENDW(t);     ROT();
            STEP(pA0, pA1, pB0, pB1, t + 1, true, (t + 4 < NT), (t + 2 < NT), (t + 2 < NT)); ENDW(t + 1); ROT();
        }
        if (has_next) { ATT_DMA_K(nx.ksrc, 0); ATT_DMA_V(nx.vsrc, 0, sl_next); ATT_DMA_K(nx.ksrc, 1); ATT_DMA_K(nx.ksrc, 2); }
        STEP(pB0, pB1, pA0, pA1, NT - 1, true, false, false, false);
        { float sacc = pB0[0] + pB0[1];
#pragma unroll
          for (int r = 2; r < 16; ++r) sacc += pB0[r];
#pragma unroll
          for (int r = 0; r < 16; ++r) sacc += pB1[r];
          l_reg += sacc;
          pw0 = (v4u){PKW(pB0, 0), PKW(pB0, 2), PKW(pB0, 4), PKW(pB0, 6)}; pw1 = (v4u){PKW(pB0, 8), PKW(pB0, 10), PKW(pB0, 12), PKW(pB0, 14)};
          pw2 = (v4u){PKW(pB1, 0), PKW(pB1, 2), PKW(pB1, 4), PKW(pB1, 6)}; pw3 = (v4u){PKW(pB1, 8), PKW(pB1, 10), PKW(pB1, 12), PKW(pB1, 14)};
          SBAR(); pv(o, vb0 + sl_cur, PAF(0), PAF(1), PAF(2), PAF(3)); }
#undef GAPA
#undef GAPB
        if (has_next) {
#pragma unroll
            for (int d0 = 0; d0 < 4; ++d0) qr[d0] = *reinterpret_cast<const bf16x8*>(nx.qw + d0 * 16);
        }
#undef DMA_K
#undef DMA_V
#undef EX
#undef PKW
#undef PAF
#undef VFR
#undef VRD
#undef KRD
#undef STEP
#undef ENDW
        { auto rr = __builtin_amdgcn_permlane32_swap(__float_as_uint(l_reg), __float_as_uint(l_reg), false, false); l_reg = __uint_as_float(rr[0]) + __uint_as_float(rr[1]); }
        int le = lane; asm volatile("" : "+v"(le));
        const int r32e = le & 31, hie = le >> 5;
        if (hie == 0) wsf[32 + r32e] = __builtin_amdgcn_rcpf(l_reg);
        LDS_WAIT();
        float rli[16];
#pragma unroll
        for (int r = 0; r < 16; ++r) rli[r] = wsf[32 + crow(r, hie)];
        LDS_WAIT();
        LAS v4u* stp = (LAS v4u*)stg + le;
        if (c == 0) {
#pragma unroll
            for (int j = 0; j < 8; ++j) { const int d0 = j >> 1, rb = (j & 1) * 8; v4u w;
                w.x = pk2(o[d0][rb + 0] * rli[rb + 0], o[d0][rb + 1] * rli[rb + 1]); w.y = pk2(o[d0][rb + 2] * rli[rb + 2], o[d0][rb + 3] * rli[rb + 3]);
                w.z = pk2(o[d0][rb + 4] * rli[rb + 4], o[d0][rb + 5] * rli[rb + 5]); w.w = pk2(o[d0][rb + 6] * rli[rb + 6], o[d0][rb + 7] * rli[rb + 7]);
                stp[64 * j] = w; }
            LDS_WAIT();
        } else {
            v4u s0[8];
#pragma unroll
            for (int j = 0; j < 8; ++j) s0[j] = stp[64 * j];
            float gsub[4];
#pragma unroll
            for (int d0 = 0; d0 < 4; ++d0) gsub[d0] = subln_g[d0 * 32 + r32e] * (1.0f - LAMBDA_INIT);
            LDS_WAIT();
            LAS unsigned short* stl = stg + (4 * hie) * 128 + r32e;
#pragma unroll
            for (int r = 0; r < 16; ++r) { float dv[4]; float ss = 0.f;
#pragma unroll
                for (int d0 = 0; d0 < 4; ++d0) { const unsigned wq = s0[2 * d0 + (r >> 3)][(r & 7) >> 1]; const float o0 = (r & 1) ? bfhi(wq) : bflo(wq);
                    dv[d0] = o0 - lam * (o[d0][r] * rli[r]); ss += dv[d0] * dv[d0]; }
                ss += __builtin_bit_cast(float, __builtin_amdgcn_update_dpp(0, __builtin_bit_cast(int, ss), 0xB1, 0xF, 0xF, true));
                ss += __builtin_bit_cast(float, __builtin_amdgcn_update_dpp(0, __builtin_bit_cast(int, ss), 0x4E, 0xF, 0xF, true));
                ss += __builtin_bit_cast(float, __builtin_amdgcn_update_dpp(0, __builtin_bit_cast(int, ss), 0x141, 0xF, 0xF, true));
                ss += __builtin_bit_cast(float, __builtin_amdgcn_update_dpp(0, __builtin_bit_cast(int, ss), 0x140, 0xF, 0xF, true));
                { const auto sw = __builtin_amdgcn_permlane16_swap(__float_as_uint(ss), __float_as_uint(ss), false, false); ss = __uint_as_float(sw[0]) + __uint_as_float(sw[1]); }
                const float rn = __builtin_amdgcn_rsqf(ss * (1.0f / 128.0f) + EPS);
#pragma unroll
                for (int d0 = 0; d0 < 4; ++d0) stl[((r & 3) + 8 * (r >> 2)) * 128 + d0 * 32] = (unsigned short)f2bf(dv[d0] * rn * gsub[d0]); }
            LDS_WAIT();
            bf16* Ow = O + (size_t)b * (DBS / 2) + (size_t)(q0 + wid * 32 + (le >> 4)) * DM + h * 128 + (le & 15) * 8;
            const LAS unsigned short* sr = stg + (le >> 4) * 128 + (le & 15) * 8;
#pragma unroll
            for (int i = 0; i < 8; ++i) { const v4u v = *(const LAS v4u*)(sr + i * 4 * 128); *(v4u*)(Ow + (long)i * 4 * DM) = v; }
        }
        if (c == 1) { WAIT_BAR(8); } else { WAIT_BAR(0); }
    }
#undef ROT
}
#undef SBAR
#undef PIN
#undef MF
#undef WAIT_BAR
constexpr int NUNITS = BATCH * NH * 16;
__device__ __forceinline__ bool unit_of(int i, int G, int vcu, int& b, int& h, int& qb) {
    const int Lx = i * G + vcu; if (Lx >= NUNITS) return false;
    const int rnd = Lx >> 8, w = Lx & 3, bh = (Lx & 255) >> 2; qb = rnd == 0 ? w : rnd == 1 ? 7 - w : rnd == 2 ? 8 + w : 15 - w; b = bh >> 3; h = bh & 7; return true;
}
__device__ __forceinline__ void phase(Frame& F) {
    float lam;
    { const float a = F.in[5][F.lane] * F.in[6][F.lane], bq = F.in[7][F.lane] * F.in[8][F.lane]; lam = expf(wave_sum(a)) - expf(wave_sum(bq)) + LAMBDA_INIT; lam = __uint_as_float(__builtin_amdgcn_readfirstlane(__float_as_uint(lam))); }
    const bf16* Q = (const bf16*)(F.ws + WS_B0 + O_Q); const bf16* K = (const bf16*)(F.ws + WS_B0 + O_K); const bf16* V = (const bf16*)(F.ws + WS_B0 + O_V); bf16* O = (bf16*)F.out;
    LAS unsigned char* lds = F.lds + RING_OFF;
    int b, h, qb;
    if (!unit_of(0, F.G, F.vcu, b, h, qb)) return;
    bf16x8 qr[4]; int sl_prev = 0, sl_cur = 0, sl_next = SLOTV;
    {
        const int wid = F.wave, lane = F.lane; const unsigned lds0 = (unsigned)(uintptr_t)lds; const unsigned kdst = lds0 + L_K + wid * 1024, vdst = lds0 + L_V + wid * 1024;
        const PassSrc p0 = pass_src(b, h, qb, 0, Q, K, V, lane, wid);
        ATT_DMA_K(p0.ksrc, 0); ATT_DMA_V(p0.vsrc, 0, 0); ATT_DMA_K(p0.ksrc, 1); ATT_DMA_K(p0.ksrc, 2);
#pragma unroll
        for (int d0 = 0; d0 < 4; ++d0) qr[d0] = *reinterpret_cast<const bf16x8*>(p0.qw + d0 * 16);
        asm volatile("s_waitcnt vmcnt(0) lgkmcnt(0)\n\ts_barrier" ::: "memory");
    }
    bool first = true;
#pragma unroll 1
    for (int i = 0;; ++i) {
        int nb, nh, nqb; const bool more = unit_of(i + 1, F.G, F.vcu, nb, nh, nqb);
        { const PassSrc nx = pass_src(b, h, qb, 1, Q, K, V, F.lane, F.wave);
          apass(b, h, qb, 0, first, true, nx, K, V, O, lds, lam, F.in[23], F.in[9], qr, sl_prev, sl_cur, sl_next); first = false; }
        { PassSrc nx = pass_src(more ? nb : b, more ? nh : h, more ? nqb : qb, 0, Q, K, V, F.lane, F.wave);
          apass(b, h, qb, 1, false, more, nx, K, V, O, lds, lam, F.in[23], F.in[9], qr, sl_prev, sl_cur, sl_next); }
        if (!more) break;
        b = nb; h = nh; qb = nqb;
    }
}
}

#ifndef MK_N_LAUNCHES
#define MK_N_LAUNCHES 1
#endif
constexpr int N_LAUNCHES = MK_N_LAUNCHES, PER_PHASE = 8;
struct Args { const float* in[24]; float* out; unsigned char* ws; int ph_lo, ph_hi, li, pad; };
__global__ void __launch_bounds__(NWAVES * 64, 2) fwd_kernel(Args args) {
    extern __shared__ __attribute__((aligned(16))) unsigned char lds[];
    Frame F;
    F.lds = (LAS unsigned char*)lds;
    F.MISC = (volatile LAS unsigned*)(F.lds + MISC_OFF);
    F.tid = threadIdx.x; F.lane = F.tid & 63; F.wave = __builtin_amdgcn_readfirstlane(F.tid >> 6);
    F.G = gridDim.x; { const int bx = blockIdx.x; F.vcu = (F.G % 8 == 0) ? (bx % 8) * (F.G / 8) + bx / 8 : bx; }
#pragma unroll
    for (int i = 0; i < 24; ++i) F.in[i] = args.in[i];
    F.out = args.out; F.ws = args.ws;
    F.ctl = (gu32*)(args.ws + WS_CTL);
    for (int u = F.tid; u < (LDS_BYTES - LDSCTL_OFF) / 4; u += NWAVES * 64) ((LAS unsigned*)(F.lds + LDSCTL_OFF))[u] = 0u;
    __syncthreads();
    const bool grouped = (F.G == 256);
    XcdBarrier bar; bar.bar = (unsigned*)(F.ctl + CW_BAR); bar.x = 0; bar.st = nullptr; bar.members = 0; XcdBarrier gbar = bar, qbar = bar;
    if (N_LAUNCHES != PER_PHASE) {
        bar = xcd_barrier_post((unsigned*)(F.ctl + CW_BAR), F.MISC + 8, (unsigned)F.G);
        if (grouped) gbar = xcd_barrier_post((unsigned*)(F.ctl + CW_BAR) + (1 + ((int)blockIdx.x & 7)) * XCD_BAR_WORDS, F.MISC + 10, (unsigned)F.G / 8u);
        if (grouped) qbar = xcd_barrier_post((unsigned*)(F.ctl + CW_QBAR) + (((int)blockIdx.x & 7) * 8 + (((int)blockIdx.x >> 3) & 7)) * XCD_BAR_WORDS, F.MISC + 12, 4u);
    }
#define GRID_BAR() do { if (N_LAUNCHES != PER_PHASE) xcd_barrier(bar); } while (0)
#define GROUP_BAR() do { if (N_LAUNCHES != PER_PHASE) { if (grouped) xcd_barrier(gbar); else xcd_barrier(bar); } } while (0)
#define QUAD_BAR() do { if (N_LAUNCHES != PER_PHASE) { if (grouped) xcd_barrier(qbar); else xcd_barrier(bar); } } while (0)
    const int lo = args.ph_lo, hi = args.ph_hi;
#define IN(k) (lo <= (k) && (k) < hi)
#define BOTH(k) (IN(k) && IN((k) + 1))
    unsigned char* ws = args.ws;
    const bf16* XN = (const bf16*)F.out; const bf16* AO = (const bf16*)F.out; const bf16* R = (const bf16*)((const unsigned char*)F.out + DO_R);
    unsigned char* wb = ws + WS_B0;

    if (IN(0)) { p0_prologue(F); if (BOTH(0)) GRID_BAR(); }

    if (IN(1)) {
        pg8::Gemm g{XN, (const bf16*)(ws + WS_WIN), nullptr, nullptr, DBS, 0, M, NIN, DM}; pg8::StaticOrder S; S.init(M, NIN, F.G, (int)blockIdx.x); S.rot = true;
        pg8::EpiIn E{(bf16*)(wb + O_Q), BST / 2, SEC / 2, F.in[3], F.in[4]};
        pg8::gemm_phase<pg8::EpiIn, pg8::StaticOrder, PG8_ALIGN, PG8_SP2>(F.lds + RING_OFF, g, S, E);
        if (IN(3)) GROUP_BAR();
    }
    if (IN(3)) { lru::phase(F); att::phase(F); if (IN(4)) GROUP_BAR(); }
    if (IN(4)) {
        pg8::Gemm g{AO, (const bf16*)(ws + WS_WPA), R, (const bf16*)(ws + WS_WPR), DBS, DBS, M, DM, DM}; pg8::PairOrder S; S.init(M, DM, F.G, (int)blockIdx.x);
        pg8::EpiMerge E{(const bf16*)(wb + O_SGA), (const bf16*)(wb + O_SGR), (bf16*)(wb + O_MERGED), BST / 2};
        pg8::gemm_phase<pg8::EpiMerge, pg8::PairOrder, PG8_ALIGN, PG8_SP2>(F.lds + RING_OFF, g, S, E);
        if (BOTH(4)) GROUP_BAR();
    }
    if (IN(5)) {
        pg8::Gemm g{(const bf16*)(wb + O_MERGED), (const bf16*)(ws + WS_WOUT), nullptr, nullptr, BST, 0, M, DM, DM}; pg8::StaticOrder S; S.init(M, DM, F.G, (int)blockIdx.x);
        pg8::EpiX1 E{F.in[0], (bf16*)(wb + O_XN2), (float*)(ws + WS_ROWSQ), BST / 2};
        pg8::gemm_phase<pg8::EpiX1, pg8::StaticOrder, PG8_ALIGN, PG8_SP2>(F.lds + RING_OFF, g, S, E);
        if (BOTH(5)) QUAD_BAR();
    }
    if (IN(6)) {
        pg8::Gemm g{(const bf16*)(wb + O_XN2), (const bf16*)(ws + WS_WUP), nullptr, nullptr, BST, 0, M, FF, DM}; pg8::StaticOrder S; S.init(M, FF, F.G, (int)blockIdx.x); S.rot = true;
        pg8::EpiUp E{(const float*)(ws + WS_ROWSQ), (bf16*)(wb + O_UP), BST / 2, {{0.f, 0.f, 0.f, 0.f}, {0.f, 0.f, 0.f, 0.f}}, -1};
        pg8::gemm_phase<pg8::EpiUp, pg8::StaticOrder, PG8_ALIGN, PG8_SP2>(F.lds + RING_OFF, g, S, E);
        if (BOTH(6)) QUAD_BAR();
    }
    if (IN(7)) {
        pg8::Gemm g{(const bf16*)(wb + O_UP), (const bf16*)(ws + WS_WDN), nullptr, nullptr, BST, 0, M, DM, FF}; pg8::StaticOrder S; S.init(M, DM, F.G, (int)blockIdx.x);
        pg8::EpiDown E{(const bf16*)(wb + O_XN2), F.out, BST / 2};
        pg8::gemm_phase<pg8::EpiDown, pg8::StaticOrder, PG8_ALIGN, PG8_SP2>(F.lds + RING_OFF, g, S, E);
    }
#undef GROUP_BAR
#undef QUAD_BAR
#undef IN
#undef BOTH
#undef GRID_BAR
}

extern "C" void kernel_launch(void* const* d_in, const int* in_sizes, int n_in, void* d_out, int out_size, void* d_ws, size_t ws_size, hipStream_t stream) {
    static int grid = 0;
    if (grid == 0) {
        if (n_in != 24 || in_sizes[0] != M * DM || out_size != M * DM || ws_size < WS_END) {
            fprintf(stderr, "kernel_launch: unexpected shapes: n_in %d in0 %d out %d ws %zu (need %zu)\n", n_in, n_in > 0 ? in_sizes[0] : -1, out_size, ws_size, (size_t)WS_END); grid = -1; return; }
        int dev = 0, cus = 0, per_cu = 0;
        if (hipGetDevice(&dev) != hipSuccess || hipDeviceGetAttribute(&cus, hipDeviceAttributeMultiprocessorCount, dev) != hipSuccess) { grid = -1; return; }
        if (hipFuncSetAttribute((const void*)fwd_kernel, hipFuncAttributeMaxDynamicSharedMemorySize, LDS_BYTES) != hipSuccess) { fprintf(stderr, "kernel_launch: hipFuncSetAttribute failed\n"); grid = -1; return; }
        if (hipOccupancyMaxActiveBlocksPerMultiprocessor(&per_cu, (const void*)fwd_kernel, NWAVES * 64, LDS_BYTES) != hipSuccess || per_cu < 1) {
            fprintf(stderr, "kernel_launch: occupancy query reports %d workgroups per CU\n", per_cu); per_cu = 1; }
        (void)hipGetLastError();
        grid = cus;
    }
    if (grid < 0) return;
    if (hipMemsetAsync((char*)d_ws + WS_CTL, 0, CTL_ZERO_BYTES, stream) != hipSuccess) { fprintf(stderr, "kernel_launch: memset failed\n"); return; }
    Args a{};
    for (int i = 0; i < 24; ++i) a.in[i] = (const float*)d_in[i];
    a.out = (float*)d_out; a.ws = (unsigned char*)d_ws;
    for (int li = 0; li < N_LAUNCHES; ++li) {
        a.ph_lo = (N_LAUNCHES == PER_PHASE) ? li : 0; a.ph_hi = (N_LAUNCHES == PER_PHASE) ? li + 1 : PER_PHASE; a.li = li;
        hipLaunchKernelGGL(fwd_kernel, dim3(grid), dim3(NWAVES * 64), LDS_BYTES, stream, a);
        const hipError_t le = hipPeekAtLastError();
        if (le != hipSuccess) { fprintf(stderr, "kernel_launch: launch %d failed: %s\n", li, hipGetErrorName(le)); break; }
    }
}
```
